# Optimizing an MI355X kernel written in HIP

```python
import jax, jax.numpy as jnp
from jax import lax
import numpy as np

D_MODEL = 1024
BATCH = 4
SEQ = 8192
DEPTH = 2

GRID_W = 64
CTX_LEN = 256
N_MIXERS = 2
EPS = 1e-6

MLA_HEADS = 8
MLA_Q_LORA = 384
MLA_KV_LORA = 256
MLA_NOPE = 128
MLA_ROPE = 64
MLA_V = 128
MLA_QK = MLA_NOPE + MLA_ROPE
ROPE_FREQ = MLA_ROPE // 4
ROPE_BASE = 10000.0
Q_BLOCK = 128

RW_HEAD = 64
RW_HEADS = D_MODEL // RW_HEAD
RW_DECAY_LORA = 64
RW_AAA_LORA = 64
RW_GATE_LORA = 160
RW_GN_EPS = 64e-5

D_FF = ((8 * D_MODEL // 3 + 255) // 256) * 256

kernel_name = 'hybrid_mla_rwkv7_prefix_dit'


def rms_norm(x, g, eps=EPS):
    xf = x.astype(jnp.float32)
    y = xf * lax.rsqrt(jnp.mean(xf * xf, axis=-1, keepdims=True) + eps)
    return (y * g.astype(jnp.float32)).astype(x.dtype)


def modulate(h, shift, scale):
    return h * (1 + scale) + shift


def swiglu(h, w1, w3, w2):
    return (jax.nn.silu(h @ w1) * (h @ w3)) @ w2


def axial_rope_tables(n_tokens):
    rows = n_tokens // GRID_W
    row = jnp.broadcast_to(jnp.arange(rows, dtype=jnp.float32)[:, None], (rows, GRID_W)).reshape(-1)
    col = jnp.broadcast_to(jnp.arange(GRID_W, dtype=jnp.float32)[None, :], (rows, GRID_W)).reshape(-1)
    inv = ROPE_BASE ** (-jnp.arange(ROPE_FREQ, dtype=jnp.float32) / ROPE_FREQ)
    ang = jnp.stack([row[:, None] * inv, col[:, None] * inv], axis=1)
    return jnp.cos(ang), jnp.sin(ang)


def apply_axial_rope(x, cos, sin):
    shp = x.shape
    xf = x.astype(jnp.float32).reshape(shp[:-1] + (2, 2, ROPE_FREQ))
    x1, x2 = xf[..., 0, :], xf[..., 1, :]
    c = cos[None, :, None]
    s = sin[None, :, None]
    out = jnp.stack([x1 * c - x2 * s, x1 * s + x2 * c], axis=-2)
    return out.reshape(shp).astype(x.dtype)


def mla_project(h, w_dqkv, g_q_lora, g_kv_lora, w_uq, w_ukv, g_qn, g_kn):
    B, L, _ = h.shape
    down = h @ w_dqkv
    cq = rms_norm(down[..., :MLA_Q_LORA], g_q_lora)
    ckv = rms_norm(down[..., MLA_Q_LORA:MLA_Q_LORA + MLA_KV_LORA], g_kv_lora)
    k_rope = down[..., MLA_Q_LORA + MLA_KV_LORA:]
    q = (cq @ w_uq).reshape(B, L, MLA_HEADS, MLA_QK)
    kv = (ckv @ w_ukv).reshape(B, L, MLA_HEADS, MLA_NOPE + MLA_V)
    k_nope, v = kv[..., :MLA_NOPE], kv[..., MLA_NOPE:]
    k = jnp.concatenate([k_nope, jnp.broadcast_to(k_rope[:, :, None, :], (B, L, MLA_HEADS, MLA_ROPE))], axis=-1)
    return rms_norm(q, g_qn), rms_norm(k, g_kn), v


def rope_tail(t, cos, sin):
    return jnp.concatenate([t[..., :MLA_NOPE], apply_axial_rope(t[..., MLA_NOPE:], cos, sin)], axis=-1)


def block_attention(q, k, v):
    B, Sq, H, Dq = q.shape
    nb = Sq // Q_BLOCK
    qb = q.reshape(B, nb, Q_BLOCK, H, Dq).transpose(1, 0, 2, 3, 4)
    scale = Dq ** -0.5

    def one(qblk):
        s = jnp.einsum('bqhd,bkhd->bhqk', qblk, k, preferred_element_type=jnp.float32) * scale
        p = jax.nn.softmax(s, axis=-1).astype(v.dtype)
        return jnp.einsum('bhqk,bkhd->bqhd', p, v)

    o = lax.map(one, qb)
    return o.transpose(1, 0, 2, 3, 4).reshape(B, Sq, H * v.shape[-1])


def mla_mixer(h_lat, h_ctx, w_dqkv, g_q_lora, g_kv_lora, w_uq, w_ukv, g_qn, g_kn, w_o, cos, sin, need_ctx_out):
    q_l, k_l, v_l = mla_project(h_lat, w_dqkv, g_q_lora, g_kv_lora, w_uq, w_ukv, g_qn, g_kn)
    q_l = rope_tail(q_l, cos, sin)
    k_l = rope_tail(k_l, cos, sin)
    q_c, k_c, v_c = mla_project(h_ctx, w_dqkv, g_q_lora, g_kv_lora, w_uq, w_ukv, g_qn, g_kn)
    k_all = jnp.concatenate([k_c, k_l], axis=1)
    v_all = jnp.concatenate([v_c, v_l], axis=1)
    o_l = block_attention(q_l, k_all, v_all) @ w_o
    o_c = block_attention(q_c, k_c, v_c) @ w_o if need_ctx_out else None
    return o_l, o_c


def centred_shift_delta(x):
    prev = jnp.pad(x[:, :-1], ((0, 0), (1, 0), (0, 0)))
    nxt = jnp.pad(x[:, 1:], ((0, 0), (0, 1), (0, 0)))
    return 0.5 * (prev + nxt) - x


def rwkv_features(h, need_out, mix, w_r, w_k, w_v, k_k, k_a, dw0, dw1, dw2, ia0, ia1, ia2, g1, g2):
    B, L, D = h.shape
    hd = (B, L, RW_HEADS, RW_HEAD)
    xx = centred_shift_delta(h)
    xr, xw, xk, xv, xa, xg = [h + xx * mix[j] for j in range(6)]
    k = xk @ w_k
    v = (xv @ w_v).reshape(hd)
    kk = (k * k_k).reshape(hd).astype(jnp.float32)
    kk = kk * lax.rsqrt(jnp.sum(kk * kk, axis=-1, keepdims=True) + 1e-12)
    dirs = []
    for d in range(2):
        w_log = -jax.nn.softplus(-(dw0[d] + jnp.tanh(xw @ dw1[d]) @ dw2[d]).astype(jnp.float32)) - 0.5
        decay = jnp.exp(-jnp.exp(w_log)).reshape(hd)
        a = jax.nn.sigmoid((ia0[d] + (xa @ ia1[d]) @ ia2[d]).astype(jnp.float32))
        k_d = (k * (1 + (a - 1) * k_a)).reshape(hd)
        a = a.reshape(hd)
        dirs.append((decay, k_d, -kk, kk * a))
    if need_out:
        r = (xr @ w_r).reshape(hd)
        g = jax.nn.sigmoid(xg @ g1) @ g2
    else:
        r, g = None, None
    return r, v, g, dirs


def wkv7_scan(r, w, k, v, a, b, state0, reverse):
    emit = r is not None
    xs = [w, k, v, a, b] + ([r] if emit else [])
    xs = tuple(jnp.moveaxis(t.astype(jnp.float32), 1, 0) for t in xs)

    def step(S, inp):
        w_t, k_t, v_t, a_t, b_t = inp[:5]
        Sa = jnp.einsum('bhvk,bhk->bhv', S, a_t)
        S = S * w_t[:, :, None, :] + Sa[..., None] * b_t[:, :, None, :] + v_t[..., None] * k_t[:, :, None, :]
        y = jnp.einsum('bhvk,bhk->bhv', S, inp[5]) if emit else None
        return S, y

    S, ys = lax.scan(step, state0, xs, reverse=reverse)
    return S, (jnp.moveaxis(ys, 0, 1) if emit else None)


def rwkv_output(y, r, v, g, dirs, r_k, gn_w, gn_b, w_o):
    B, L, H, N = y.shape
    mu = jnp.mean(y, axis=-1, keepdims=True)
    var = jnp.mean(jnp.square(y - mu), axis=-1, keepdims=True)
    yn = (y - mu) * lax.rsqrt(var + RW_GN_EPS) * gn_w.reshape(H, N) + gn_b.reshape(H, N)
    bonus = sum(jnp.sum(r * dd[1] * r_k, axis=-1, keepdims=True) for dd in dirs) * v
    return ((yn + bonus).reshape(B, L, H * N).astype(g.dtype) * g) @ w_o


def rwkv_mixer(h_lat, h_ctx, mix, w_r, w_k, w_v, w_o, k_k, k_a, r_k, dw0, dw1, dw2, ia0, ia1, ia2, g1, g2, gn_w, gn_b, need_ctx_out):
    fp = (mix, w_r, w_k, w_v, k_k, k_a, dw0, dw1, dw2, ia0, ia1, ia2, g1, g2)
    r_l, v_l, g_l, dirs_l = rwkv_features(h_lat, True, *fp)
    r_c, v_c, g_c, dirs_c = rwkv_features(h_ctx, need_ctx_out, *fp)
    B = h_lat.shape[0]
    y_l, y_c = 0.0, 0.0
    for d, rev in enumerate((False, True)):
        state0 = jnp.zeros((B, RW_HEADS, RW_HEAD, RW_HEAD), jnp.float32)
        dc, kc, ac, bc = dirs_c[d]
        S_c, yc = wkv7_scan(r_c, dc, kc, v_c, ac, bc, state0, rev)
        dl, kl, al, bl = dirs_l[d]
        _, yl = wkv7_scan(r_l, dl, kl, v_l, al, bl, S_c, rev)
        y_l = y_l + yl
        if need_ctx_out:
            y_c = y_c + yc
    o_l = rwkv_output(y_l, r_l, v_l, g_l, dirs_l, r_k, gn_w, gn_b, w_o)
    o_c = rwkv_output(y_c, r_c, v_c, g_c, dirs_c, r_k, gn_w, gn_b, w_o) if need_ctx_out else None
    return o_l, o_c


def setup_inputs(seed: int = 0) -> dict:
    key = jax.random.key(seed)
    ks = iter(jax.random.split(key, 48))
    f32 = jnp.float32

    def nrm(shape, scale):
        return jax.random.normal(next(ks), shape, f32) * scale

    def gain(shape):
        return 1.0 + 0.05 * jax.random.normal(next(ks), shape, f32)

    def unif(shape, lo, hi):
        return jax.random.uniform(next(ks), shape, f32, lo, hi)

    D = D_MODEL
    n_a = (DEPTH + N_MIXERS - 1) // N_MIXERS
    n_b = DEPTH // N_MIXERS
    return {
        'x': nrm((BATCH, SEQ, D), 1.0),
        'c': nrm((BATCH, D), 1.0),
        'ctx': nrm((BATCH, CTX_LEN, D), 1.0),
        'c_ctx': nrm((D,), 1.0),
        'ada_w': nrm((DEPTH, D, 6 * D), 0.5 * D ** -0.5),
        'ada_b': nrm((DEPTH, 6 * D), 0.02),
        'norm_mix': gain((DEPTH, D)),
        'norm_ffn': gain((DEPTH, D)),
        'ffn_w1': nrm((DEPTH, D, D_FF), D ** -0.5),
        'ffn_w3': nrm((DEPTH, D, D_FF), D ** -0.5),
        'ffn_w2': nrm((DEPTH, D_FF, D), D_FF ** -0.5),
        'mla_w_dqkv': nrm((n_a, D, MLA_Q_LORA + MLA_KV_LORA + MLA_ROPE), D ** -0.5),
        'mla_g_q_lora': gain((n_a, MLA_Q_LORA)),
        'mla_g_kv_lora': gain((n_a, MLA_KV_LORA)),
        'mla_w_uq': nrm((n_a, MLA_Q_LORA, MLA_HEADS * MLA_QK), MLA_Q_LORA ** -0.5),
        'mla_w_ukv': nrm((n_a, MLA_KV_LORA, MLA_HEADS * (MLA_NOPE + MLA_V)), MLA_KV_LORA ** -0.5),
        'mla_g_qn': gain((n_a, MLA_QK)),
        'mla_g_kn': gain((n_a, MLA_QK)),
        'mla_w_o': nrm((n_a, MLA_HEADS * MLA_V, D), (MLA_HEADS * MLA_V) ** -0.5),
        'rw_mix': unif((n_b, 6, D), 0.0, 1.0),
        'rw_w_r': nrm((n_b, D, D), D ** -0.5),
        'rw_w_k': nrm((n_b, D, D), D ** -0.5),
        'rw_w_v': nrm((n_b, D, D), D ** -0.5),
        'rw_w_o': nrm((n_b, D, D), D ** -0.5),
        'rw_k_k': 0.85 + nrm((n_b, D), 0.05),
        'rw_k_a': gain((n_b, D)),
        'rw_r_k': nrm((n_b, RW_HEADS, RW_HEAD), 0.1),
        'rw_decay_w0': unif((n_b, 2, D), -6.0, 0.0),
        'rw_decay_w1': nrm((n_b, 2, D, RW_DECAY_LORA), D ** -0.5),
        'rw_decay_w2': nrm((n_b, 2, RW_DECAY_LORA, D), 0.5 * RW_DECAY_LORA ** -0.5),
        'rw_iclr_a0': nrm((n_b, 2, D), 0.5),
        'rw_iclr_a1': nrm((n_b, 2, D, RW_AAA_LORA), D ** -0.5),
        'rw_iclr_a2': nrm((n_b, 2, RW_AAA_LORA, D), 0.5 * RW_AAA_LORA ** -0.5),
        'rw_gate_g1': nrm((n_b, D, RW_GATE_LORA), D ** -0.5),
        'rw_gate_g2': nrm((n_b, RW_GATE_LORA, D), RW_GATE_LORA ** -0.5),
        'rw_gn_w': gain((n_b, D)),
        'rw_gn_b': nrm((n_b, D), 0.02),
    }


def reference(x, c, ctx, c_ctx, ada_w, ada_b, norm_mix, norm_ffn, ffn_w1, ffn_w3, ffn_w2,
              mla_w_dqkv, mla_g_q_lora, mla_g_kv_lora, mla_w_uq, mla_w_ukv, mla_g_qn, mla_g_kn, mla_w_o,
              rw_mix, rw_w_r, rw_w_k, rw_w_v, rw_w_o, rw_k_k, rw_k_a, rw_r_k,
              rw_decay_w0, rw_decay_w1, rw_decay_w2, rw_iclr_a0, rw_iclr_a1, rw_iclr_a2,
              rw_gate_g1, rw_gate_g2, rw_gn_w, rw_gn_b):
    n_lat = x.shape[1]
    cos, sin = axial_rope_tables(n_lat)
    for i in range(DEPTH):
        last = i == DEPTH - 1
        j = i // N_MIXERS
        mod_l = (jax.nn.silu(c) @ ada_w[i] + ada_b[i])[:, None, :]
        mod_c = jax.nn.silu(c_ctx) @ ada_w[i] + ada_b[i]
        sh_m, sc_m, ga_m, sh_f, sc_f, ga_f = jnp.split(mod_l, 6, axis=-1)
        csh_m, csc_m, cga_m, csh_f, csc_f, cga_f = jnp.split(mod_c, 6, axis=-1)
        h_l = modulate(rms_norm(x, norm_mix[i]), sh_m, sc_m)
        h_c = modulate(rms_norm(ctx, norm_mix[i]), csh_m, csc_m)
        if i % N_MIXERS == 0:
            o_l, o_c = mla_mixer(h_l, h_c, mla_w_dqkv[j], mla_g_q_lora[j], mla_g_kv_lora[j], mla_w_uq[j],
                                 mla_w_ukv[j], mla_g_qn[j], mla_g_kn[j], mla_w_o[j], cos, sin, not last)
        else:
            o_l, o_c = rwkv_mixer(h_l, h_c, rw_mix[j], rw_w_r[j], rw_w_k[j], rw_w_v[j], rw_w_o[j], rw_k_k[j],
                                  rw_k_a[j], rw_r_k[j], rw_decay_w0[j], rw_decay_w1[j], rw_decay_w2[j],
                                  rw_iclr_a0[j], rw_iclr_a1[j], rw_iclr_a2[j], rw_gate_g1[j], rw_gate_g2[j],
                                  rw_gn_w[j], rw_gn_b[j], not last)
        x = x + ga_m * o_l
        x = x + ga_f * swiglu(modulate(rms_norm(x, norm_ffn[i]), sh_f, sc_f), ffn_w1[i], ffn_w3[i], ffn_w2[i])
        if not last:
            ctx = ctx + cga_m * o_c
            ctx = ctx + cga_f * swiglu(modulate(rms_norm(ctx, norm_ffn[i]), csh_f, csc_f), ffn_w1[i], ffn_w3[i], ffn_w2[i])
    return x
```

```cpp
#include <hip/hip_runtime.h>
#include <hip/hip_cooperative_groups.h>
#include <stdint.h>
#include <stdio.h>
namespace cg = cooperative_groups;

#define LAS __attribute__((address_space(3)))
typedef unsigned short u16;
typedef __bf16 bf16x8 __attribute__((ext_vector_type(8)));
typedef __bf16 bf16x2 __attribute__((ext_vector_type(2)));
typedef float f32x2 __attribute__((ext_vector_type(2)));
typedef float f32x16 __attribute__((ext_vector_type(16)));
typedef float f32x4 __attribute__((ext_vector_type(4)));
typedef unsigned u32x4 __attribute__((ext_vector_type(4)));

constexpr int T_ALL = 33792, T_LAT = 32768;
constexpr int DFF = 2816;
constexpr size_t MiB = 1048576;
constexpr size_t OFF_MOD = 0;
constexpr size_t OFF_ROPE = 256 * 1024;
constexpr size_t OFF_SSP = 512 * 1024;
constexpr size_t OFF_KROPE = 2 * MiB;
constexpr size_t OFF_CTXR = 11 * MiB;
constexpr size_t OFF_BONUS = 15 * MiB;
constexpr size_t OFF_BAR = 19 * MiB;
constexpr size_t OFF_W = 20 * MiB;
constexpr size_t OFF_A = 69 * MiB;
constexpr size_t OFF_B = 135 * MiB;
constexpr size_t OFF_C = 201 * MiB;
constexpr size_t OFF_E = 399 * MiB;
constexpr size_t OFF_F = 432 * MiB;
constexpr size_t W_DQ = 0, W_UQ = 720896, W_UKV = 1310720, W_O0 = 1835008, W_13 = 2883584, W_2 = 14417920,
                 W_P1 = 20185088, W_O1 = 23855104, W_DW2 = 24903680, W_IA2 = 25034752, W_G2 = 25165824;
constexpr size_t W13_SZ = 5767168, W2_SZ = 2883584;

struct Params {
  const float* in[37];
  float* out;
  char* ws;
};

__device__ __forceinline__ const float* inp(const Params& p, int i) {
  int z;
  asm volatile("s_mov_b32 %0, 0" : "=s"(z));
  return p.in[i + z];
}
__device__ __forceinline__ char* wsp(const Params& p) {
  int z;
  asm volatile("s_mov_b32 %0, 0" : "=s"(z));
  return (&p.ws)[z];
}
__device__ __forceinline__ float* outp(const Params& p) {
  int z;
  asm volatile("s_mov_b32 %0, 0" : "=s"(z));
  return (&p.out)[z];
}
__device__ __forceinline__ float bf2f(u16 v) { return __uint_as_float(((unsigned)v) << 16); }
__device__ __forceinline__ unsigned pack2(float a, float b) {
  f32x2 f = {a, b};
  bf16x2 h = __builtin_convertvector(f, bf16x2);
  return __builtin_bit_cast(unsigned, h);
}
__device__ __forceinline__ u16 f2bf(float a) { return (u16)(pack2(a, 0.f) & 0xffffu); }
__device__ __forceinline__ float lo2f(unsigned u) { return __uint_as_float(u << 16); }
__device__ __forceinline__ float hi2f(unsigned u) { return __uint_as_float(u & 0xffff0000u); }

template <int CTRL>
__device__ __forceinline__ float dpp_f(float v) {
  return __int_as_float(__builtin_amdgcn_update_dpp(0, __float_as_int(v), CTRL, 0xF, 0xF, true));
}
__device__ __forceinline__ float red4(float v) { v += dpp_f<0xB1>(v); v += dpp_f<0x4E>(v); return v; }
__device__ __forceinline__ float red8(float v) { v = red4(v); v += dpp_f<0x141>(v); return v; }
__device__ __forceinline__ float red16(float v) { v = red8(v); v += dpp_f<0x140>(v); return v; }
__device__ __forceinline__ float swz16(float v) { return __int_as_float(__builtin_amdgcn_ds_swizzle(__float_as_int(v), 0x401F)); }
__device__ __forceinline__ float red32(float v) { v = red16(v); v += swz16(v); return v; }
__device__ __forceinline__ float max_x32(float v) {
  auto r = __builtin_amdgcn_permlane32_swap(__float_as_uint(v), __float_as_uint(v), false, false);
  return fmaxf(__uint_as_float(r[0]), __uint_as_float(r[1]));
}
__device__ __forceinline__ float red64(float v) { v = red32(v); v += __shfl_xor(v, 32); return v; }

__device__ __forceinline__ void lds_barrier() { asm volatile("s_waitcnt lgkmcnt(0)\n\ts_barrier" ::: "memory"); }
__device__ __forceinline__ float silu_f(float x) { return x * __builtin_amdgcn_rcpf(1.f + __expf(-x)); }
__device__ __forceinline__ float sigmoid_f(float x) { return __builtin_amdgcn_rcpf(1.f + __expf(-x)); }
__device__ __forceinline__ float tanh_f(float x) { float e = __expf(2.f * x); return 1.f - 2.f / (e + 1.f); }
__device__ __forceinline__ int roff(int i, int g) { return (i & 3) + 8 * (i >> 2) + 4 * g; }
__device__ __forceinline__ void pair_store_b(__amdgpu_buffer_rsrc_t rs, int voff, int soff, float va, float vb, int odd) {
  const float na = dpp_f<0xB1>(va), nb = dpp_f<0xB1>(vb);
  const unsigned w = odd ? pack2(nb, vb) : pack2(va, na);
  __builtin_amdgcn_raw_buffer_store_b32(w, rs, voff, soff, 0);
}
__device__ __forceinline__ void pair_store(u16* base, size_t ld, int rA, int col, float va, float vb, int lane) {
  const float na = dpp_f<0xB1>(va), nb = dpp_f<0xB1>(vb);
  const bool odd = lane & 1;
  const unsigned w = odd ? pack2(nb, vb) : pack2(va, na);
  *(unsigned*)(base + (size_t)(rA + (odd ? 1 : 0)) * ld + (col & ~1)) = w;
}

__device__ __forceinline__ f32x16 mfma32(bf16x8 a, bf16x8 b, f32x16 c) { return __builtin_amdgcn_mfma_f32_32x32x16_bf16(a, b, c, 0, 0, 0); }
__device__ __forceinline__ f32x4 mfma16(bf16x8 a, bf16x8 b, f32x4 c) { return __builtin_amdgcn_mfma_f32_16x16x32_bf16(a, b, c, 0, 0, 0); }

struct ALPlain {
  const u16* A; int lda;
  __device__ __forceinline__ uint4 load(int m, int k) const { return *(const uint4*)(A + (size_t)m * lda + k); }
};
struct ALMix {
  const u16* h; const u16* xx; const float* mix;
  __device__ __forceinline__ uint4 load(int m, int k) const {
    uint4 hv = *(const uint4*)(h + (size_t)m * 1024 + k);
    uint4 xv = *(const uint4*)(xx + (size_t)m * 1024 + k);
    float4 m0 = *(const float4*)(mix + k), m1 = *(const float4*)(mix + k + 4);
    uint4 r;
    r.x = pack2(lo2f(hv.x) + lo2f(xv.x) * m0.x, hi2f(hv.x) + hi2f(xv.x) * m0.y);
    r.y = pack2(lo2f(hv.y) + lo2f(xv.y) * m0.z, hi2f(hv.y) + hi2f(xv.y) * m0.w);
    r.z = pack2(lo2f(hv.z) + lo2f(xv.z) * m1.x, hi2f(hv.z) + hi2f(xv.z) * m1.y);
    r.w = pack2(lo2f(hv.w) + lo2f(xv.w) * m1.z, hi2f(hv.w) + hi2f(xv.w) * m1.w);
    return r;
  }
};

template <int TN, int BK, class AL, class EP>
__device__ __forceinline__ void gemm_tile(char* smem, const AL& al, const u16* __restrict__ Bw, int ldb, int nvalid,
                                          int K, int m0, int n0, const EP& ep) {
  constexpr int LS = BK + 8;
  constexpr int CPR = BK / 8;
  constexpr int RPI = 512 / CPR;
  constexpr int NA = 256 / RPI, NB = TN * 32 / RPI;
  u16* As = (u16*)smem;
  u16* Bs = As + 256 * LS;
  const int tid = threadIdx.x, lane = tid & 63, wid = tid >> 6, lr = lane & 31, g = lane >> 5;
  f32x16 acc[TN];
#pragma unroll
  for (int nt = 0; nt < TN; ++nt)
#pragma unroll
    for (int i = 0; i < 16; ++i) acc[nt][i] = 0.f;
  uint4 ra[NA], rb[NB];
  const int crow = tid / CPR, ckc = (tid % CPR) * 8;
  auto gload = [&](int k0) {
#pragma unroll
    for (int i = 0; i < NA; ++i) ra[i] = al.load(m0 + crow + RPI * i, k0 + ckc);
#pragma unroll
    for (int i = 0; i < NB; ++i) {
      int n = n0 + crow + RPI * i;
      rb[i] = (n < nvalid) ? *(const uint4*)(Bw + (size_t)n * ldb + k0 + ckc) : make_uint4(0, 0, 0, 0);
    }
  };
  gload(0);
  const int nk = K / BK;
  for (int kt = 0; kt < nk; ++kt) {
    __syncthreads();
#pragma unroll
    for (int i = 0; i < NA; ++i) *(uint4*)(As + (crow + RPI * i) * LS + ckc) = ra[i];
#pragma unroll
    for (int i = 0; i < NB; ++i) *(uint4*)(Bs + (crow + RPI * i) * LS + ckc) = rb[i];
    __syncthreads();
    if (kt + 1 < nk) gload((kt + 1) * BK);
#pragma unroll(TN > 4 ? 1 : 4)
    for (int ks = 0; ks < BK / 16; ++ks) {
      bf16x8 a = *(const bf16x8*)(As + (wid * 32 + lr) * LS + ks * 16 + g * 8);
#pragma unroll
      for (int nt = 0; nt < TN; ++nt) {
        bf16x8 b = *(const bf16x8*)(Bs + (nt * 32 + lr) * LS + ks * 16 + g * 8);
        acc[nt] = mfma32(a, b, acc[nt]);
      }
    }
  }
  int lane2 = lane;
  asm volatile("" : "+v"(lane2));
  ep(acc, m0 + wid * 32, n0, lane2);
}

#define WAIT_V(n) asm volatile("s_waitcnt vmcnt(%0)" ::"n"(n) : "memory")
template <int TNW, class EP>
__device__ __forceinline__ void gemm_tile_w8(char* smem, const u16* __restrict__ A, int lda, const u16* __restrict__ Bw,
                                             int ldb, int nvalid, int K, int m0, int n0, const EP& ep) {
  constexpr int ABYTES = 256 * 128, BBYTES = TNW * 64 * 128, STAGE = ABYTES + BBYTES;
  const int tid = threadIdx.x, lane = tid & 63, lr = lane & 31, g = lane >> 5;
  const int wid = __builtin_amdgcn_readfirstlane(tid >> 6);
  const int wm = wid >> 1, wn = wid & 1;
  const int rl = lane >> 3, cp = lane & 7;
  unsigned ag[4], bg[TNW];
  const __amdgpu_buffer_rsrc_t rsA = __builtin_amdgcn_make_buffer_rsrc((void*)A, 0, 0x7fffffff, 0x00020000);
  const __amdgpu_buffer_rsrc_t rsB = __builtin_amdgcn_make_buffer_rsrc((void*)Bw, 0, 0x7fffffff, 0x00020000);
#pragma unroll
  for (int i = 0; i < 4; ++i) {
    const int row = (i * 8 + wid) * 8 + rl;
    const int c = cp ^ ((row >> 1) & 7);
    ag[i] = (unsigned)((m0 + row) * lda + c * 8) * 2u;
  }
#pragma unroll
  for (int i = 0; i < TNW; ++i) {
    const int row = (i * 8 + wid) * 8 + rl;
    const int c = cp ^ ((row >> 1) & 7);
    int n = n0 + row;
    n = n < nvalid ? n : nvalid - 1;
    bg[i] = (unsigned)(n * ldb + c * 8) * 2u;
  }
#define GLDS_STAGE(BUF, K0)                                                                                          \
  {                                                                                                                  \
    _Pragma("unroll") for (int i = 0; i < 4; ++i) __builtin_amdgcn_raw_ptr_buffer_load_lds(                          \
        rsA, (LAS void*)(smem + (BUF) * STAGE + (i * 8 + wid) * 1024), 16, ag[i], (K0) * 2, 0, 0);                   \
    _Pragma("unroll") for (int i = 0; i < TNW; ++i) __builtin_amdgcn_raw_ptr_buffer_load_lds(                        \
        rsB, (LAS void*)(smem + (BUF) * STAGE + ABYTES + (i * 8 + wid) * 1024), 16, bg[i], (K0) * 2, 0, 0);          \
  }
  f32x16 acc[2][TNW];
#pragma unroll
  for (int tm = 0; tm < 2; ++tm)
#pragma unroll
    for (int nt = 0; nt < TNW; ++nt)
#pragma unroll
      for (int i = 0; i < 16; ++i) acc[tm][nt][i] = 0.f;
  const int sw = (lr >> 1) & 7;
  const int aoff = (wm * 64 + lr) * 128, boff = ABYTES + (wn * TNW * 32 + lr) * 128;
  const int nk = K >> 6;
  WAIT_V(0);
  __syncthreads();
  GLDS_STAGE(0, 0)
  int cur = 0;
  for (int kt = 0; kt < nk; ++kt) {
    WAIT_V(0);
    lds_barrier();
    if (kt + 1 < nk) GLDS_STAGE(cur ^ 1, (kt + 1) * 64)
    const char* sb = smem + cur * STAGE;
#pragma unroll 2
    for (int ks = 0; ks < 4; ++ks) {
      const int pos = ((ks * 2 + g) ^ sw) * 16;
      bf16x8 a0 = *(const bf16x8*)(sb + aoff + pos);
      bf16x8 a1 = *(const bf16x8*)(sb + aoff + 4096 + pos);
#pragma unroll
      for (int nt = 0; nt < TNW; ++nt) {
        bf16x8 b = *(const bf16x8*)(sb + boff + nt * 4096 + pos);
        acc[0][nt] = mfma32(a0, b, acc[0][nt]);
        acc[1][nt] = mfma32(a1, b, acc[1][nt]);
      }
    }
    cur ^= 1;
  }
#undef GLDS_STAGE
  int lane2 = lane;
  asm volatile("" : "+v"(lane2));
  ep(acc[0], m0 + wm * 64, n0 + wn * TNW * 32, lane2);
  asm volatile("" : "+v"(lane2));
  ep(acc[1], m0 + wm * 64 + 32, n0 + wn * TNW * 32, lane2);
}

template <class EP>
__device__ __forceinline__ void gemm_tile_w8m(char* smem, const u16* __restrict__ H, const u16* __restrict__ X,
                                              const float* __restrict__ mix, const u16* __restrict__ Bw, int ldb,
                                              int K, int m0, int n0, const EP& ep) {
  constexpr int TNW = 4;
  constexpr int ABYTES = 256 * 128, BBYTES = TNW * 64 * 128, STAGE = ABYTES + BBYTES;
  const int tid = threadIdx.x, lane = tid & 63, lr = lane & 31, g = lane >> 5;
  const int wid = __builtin_amdgcn_readfirstlane(tid >> 6);
  const int wm = wid >> 1, wn = wid & 1;
  const int rl = lane >> 3, cp = lane & 7;
  unsigned bg[TNW];
#pragma unroll
  for (int i = 0; i < TNW; ++i) {
    const int row = (i * 8 + wid) * 8 + rl;
    const int c = cp ^ ((row >> 1) & 7);
    bg[i] = (unsigned)((n0 + row) * ldb + c * 8) * 2u;
  }
  const int ac = tid & 7, ar0 = tid >> 3;
  const unsigned aoffg = (unsigned)((m0 + ar0) * 1024 + ac * 8);
  u32x4 rh[4], rx[4];
  const __amdgpu_buffer_rsrc_t rsH = __builtin_amdgcn_make_buffer_rsrc((void*)H, 0, 0x7fffffff, 0x00020000);
  const __amdgpu_buffer_rsrc_t rsX = __builtin_amdgcn_make_buffer_rsrc((void*)X, 0, 0x7fffffff, 0x00020000);
  const int aoffb = (int)(aoffg * 2u);
#define LOAD_A(K0)                                                                                   \
  {                                                                                                  \
    _Pragma("unroll") for (int i = 0; i < 4; ++i) {                                                  \
      rh[i] = __builtin_amdgcn_raw_buffer_load_b128(rsH, aoffb, (i * 65536 + (K0)) * 2, 0);          \
      rx[i] = __builtin_amdgcn_raw_buffer_load_b128(rsX, aoffb, (i * 65536 + (K0)) * 2, 0);          \
    }                                                                                                \
  }
  const __amdgpu_buffer_rsrc_t rsB = __builtin_amdgcn_make_buffer_rsrc((void*)Bw, 0, 0x7fffffff, 0x00020000);
#define GLDS_B(BUF, K0)                                                                              \
  {                                                                                                  \
    _Pragma("unroll") for (int i = 0; i < TNW; ++i) __builtin_amdgcn_raw_ptr_buffer_load_lds(        \
        rsB, (LAS void*)(smem + (BUF) * STAGE + ABYTES + (i * 8 + wid) * 1024), 16, bg[i], (K0) * 2, 0, 0); \
  }
  f32x16 acc[2][TNW];
#pragma unroll
  for (int tm = 0; tm < 2; ++tm)
#pragma unroll
    for (int nt = 0; nt < TNW; ++nt)
#pragma unroll
      for (int i = 0; i < 16; ++i) acc[tm][nt][i] = 0.f;
  const int sw = (lr >> 1) & 7;
  const int aoff = (wm * 64 + lr) * 128, boff = ABYTES + (wn * TNW * 32 + lr) * 128;
  const int nk = K >> 6;
  WAIT_V(0);
  __syncthreads();
  GLDS_B(0, 0)
  LOAD_A(0)
  int cur = 0;
  for (int kt = 0; kt < nk; ++kt) {
    const float4 m0v = *(const float4*)(mix + kt * 64 + ac * 8), m1v = *(const float4*)(mix + kt * 64 + ac * 8 + 4);
    WAIT_V(0);
    {
      char* ab = smem + cur * STAGE;
#pragma unroll
      for (int i = 0; i < 4; ++i) {
        const int row = ar0 + 64 * i;
        u32x4 o;
        o[0] = pack2(lo2f(rh[i][0]) + lo2f(rx[i][0]) * m0v.x, hi2f(rh[i][0]) + hi2f(rx[i][0]) * m0v.y);
        o[1] = pack2(lo2f(rh[i][1]) + lo2f(rx[i][1]) * m0v.z, hi2f(rh[i][1]) + hi2f(rx[i][1]) * m0v.w);
        o[2] = pack2(lo2f(rh[i][2]) + lo2f(rx[i][2]) * m1v.x, hi2f(rh[i][2]) + hi2f(rx[i][2]) * m1v.y);
        o[3] = pack2(lo2f(rh[i][3]) + lo2f(rx[i][3]) * m1v.z, hi2f(rh[i][3]) + hi2f(rx[i][3]) * m1v.w);
        *(u32x4*)(ab + row * 128 + ((ac ^ ((row >> 1) & 7)) << 4)) = o;
      }
    }
    lds_barrier();
    if (kt + 1 < nk) { GLDS_B(cur ^ 1, (kt + 1) * 64) LOAD_A((kt + 1) * 64) }
    const char* sb = smem + cur * STAGE;
#pragma unroll 2
    for (int ks = 0; ks < 4; ++ks) {
      const int pos = ((ks * 2 + g) ^ sw) * 16;
      bf16x8 a0 = *(const bf16x8*)(sb + aoff + pos);
      bf16x8 a1 = *(const bf16x8*)(sb + aoff + 4096 + pos);
#pragma unroll
      for (int nt = 0; nt < TNW; ++nt) {
        bf16x8 bb = *(const bf16x8*)(sb + boff + nt * 4096 + pos);
        acc[0][nt] = mfma32(a0, bb, acc[0][nt]);
        acc[1][nt] = mfma32(a1, bb, acc[1][nt]);
      }
    }
    cur ^= 1;
  }
#undef LOAD_A
#undef GLDS_B
  int lane2 = lane;
  asm volatile("" : "+v"(lane2));
  ep(acc[0], m0 + wm * 64, n0 + wn * TNW * 32, lane2);
  asm volatile("" : "+v"(lane2));
  ep(acc[1], m0 + wm * 64 + 32, n0 + wn * TNW * 32, lane2);
}

struct EpDown {
  u16* down; float* krope; float* ssp;
  __device__ __forceinline__ void operator()(f32x16 (&acc)[4], int mw, int n0, int lane) const {
    const int lr = lane & 31, g = lane >> 5;
    float ssq[16];
#pragma unroll
    for (int i = 0; i < 16; ++i) ssq[i] = 0.f;
#pragma unroll
    for (int nt = 0; nt < 4; ++nt) {
      const int col = n0 + nt * 32 + lr;
#pragma unroll
      for (int i = 0; i < 16; ++i) {
        const int row = mw + roff(i, g);
        const float v = acc[nt][i];
        if (col < 640) { down[(size_t)row * 640 + col] = f2bf(v); ssq[i] += v * v; }
        else if (col < 704) { krope[(size_t)row * 64 + col - 640] = v; ssq[i] += v * v; }
      }
    }
#pragma unroll
    for (int i = 0; i < 16; ++i) {
      float s = red32(ssq[i]);
      if (lr == 0) ssp[(size_t)(mw + roff(i, g)) * 8 + (n0 >> 7)] = s;
    }
  }
};

constexpr float QSCALE = 0.07216878364870323f * 1.4426950408889634f;

struct EpQ {
  u16* Ql; u16* Qc; const float* ssp; const float* gq; const float* ropec; const float* ropes;
  __device__ __forceinline__ void operator()(f32x16 (&acc)[6], int mw, int n0, int lane) const {
    const int lr = lane & 31, g = lane >> 5;
    const int h = n0 / 192;
    int b, s0, isc;
    if (mw < T_LAT) { b = mw >> 13; s0 = mw & 8191; isc = 0; } else { int u = mw - T_LAT; b = u >> 8; s0 = u & 255; isc = 1; }
    float gv[6];
#pragma unroll
    for (int nt = 0; nt < 6; ++nt) gv[nt] = gq[nt * 32 + lr];
#pragma unroll
    for (int i = 0; i < 16; ++i) {
      const int row = mw + roff(i, g);
      const float* sp = ssp + (size_t)row * 8;
      const float rsq = rsqrtf((sp[0] + sp[1] + sp[2]) * (1.f / 384.f) + 1e-6f);
      float ss = 0.f;
#pragma unroll
      for (int nt = 0; nt < 6; ++nt) { float v = acc[nt][i] * rsq; acc[nt][i] = v; ss += v * v; }
      ss = red32(ss);
      const float rn = rsqrtf(ss * (1.f / 192.f) + 1e-6f);
#pragma unroll
      for (int nt = 0; nt < 6; ++nt) acc[nt][i] *= rn * gv[nt];
      if ((i & 3) == 3) asm volatile("" ::: "memory");
    }
    if (!isc) {
      const int f = lr & 15, hi = lr >> 4;
#pragma unroll
      for (int i = 0; i < 16; ++i) {
        const int s = s0 + roff(i, g);
        const int p0 = s >> 6, p1 = 128 + (s & 63);
        float cs = ropec[p0 * 16 + f], sn = ropes[p0 * 16 + f];
        float x = acc[4][i], px = swz16(x);
        acc[4][i] = hi ? (px * sn + x * cs) : (x * cs - px * sn);
        cs = ropec[p1 * 16 + f]; sn = ropes[p1 * 16 + f];
        x = acc[5][i]; px = swz16(x);
        acc[5][i] = hi ? (px * sn + x * cs) : (x * cs - px * sn);
        }
    }
    u16* base = isc ? (Qc + ((size_t)(b * 8 + h) * 256 + s0) * 192) : (Ql + ((size_t)(b * 8 + h) * 8192 + s0) * 192);
#pragma unroll
    for (int nt = 0; nt < 6; ++nt)
#pragma unroll
      for (int i = 0; i < 16; i += 2)
        pair_store(base, 192, roff(i, g), nt * 32 + lr, acc[nt][i] * QSCALE, acc[nt][i + 1] * QSCALE, lane);
  }
};

struct EpKV {
  u16* Kb; u16* Vt; const float* ssp; const float* krope; const float* gk; const float* ropec; const float* ropes;
  __device__ __forceinline__ void operator()(f32x16 (&acc)[4], int mw, int n0, int lane) const {
    const int lr = lane & 31, g = lane >> 5;
    const int h = n0 >> 8, isv = (n0 >> 7) & 1;
    int b, s0, isc;
    if (mw < T_LAT) { b = mw >> 13; s0 = mw & 8191; isc = 0; } else { int u = mw - T_LAT; b = u >> 8; s0 = u & 255; isc = 1; }
    const int key0 = isc ? s0 : 256 + s0;
    const int bh = b * 8 + h;
    float rs[16];
#pragma unroll
    for (int i = 0; i < 16; ++i) {
      const float* sp = ssp + (size_t)(mw + roff(i, g)) * 8;
      rs[i] = rsqrtf((sp[3] + sp[4]) * (1.f / 256.f) + 1e-6f);
    }
    if (isv) {
#pragma unroll
      for (int nt = 0; nt < 4; ++nt) {
        u16* vrow = Vt + ((size_t)bh * 128 + nt * 32 + lr) * 8448 + key0;
#pragma unroll
        for (int ap = 0; ap < 2; ++ap) {
          const int a0 = 8 * ap;
          uint4 w;
          w.x = pack2(acc[nt][a0 + 0] * rs[a0 + 0], acc[nt][a0 + 1] * rs[a0 + 1]);
          w.y = pack2(acc[nt][a0 + 2] * rs[a0 + 2], acc[nt][a0 + 3] * rs[a0 + 3]);
          w.z = pack2(acc[nt][a0 + 4] * rs[a0 + 4], acc[nt][a0 + 5] * rs[a0 + 5]);
          w.w = pack2(acc[nt][a0 + 6] * rs[a0 + 6], acc[nt][a0 + 7] * rs[a0 + 7]);
          *(uint4*)(vrow + 16 * ap + 8 * g) = w;
        }
      }
    } else {
      float gv[4];
#pragma unroll
      for (int nt = 0; nt < 4; ++nt) gv[nt] = gk[nt * 32 + lr];
      const float g0 = gk[128 + lr], g1 = gk[160 + lr];
      const int f = lr & 15, hi = lr >> 4;
      float t0[16], t1[16];
#pragma unroll
      for (int i = 0; i < 16; ++i) {
        const int r = roff(i, g);
        const int row = mw + r;
        float ss = 0.f;
#pragma unroll
        for (int nt = 0; nt < 4; ++nt) { float v = acc[nt][i] * rs[i]; acc[nt][i] = v; ss += v * v; }
        ss = red32(ss) + ssp[(size_t)row * 8 + 5];
        const float rk = rsqrtf(ss * (1.f / 192.f) + 1e-6f);
#pragma unroll
        for (int nt = 0; nt < 4; ++nt) acc[nt][i] *= rk * gv[nt];
        float x0 = krope[(size_t)row * 64 + lr] * rk * g0;
        float x1 = krope[(size_t)row * 64 + 32 + lr] * rk * g1;
        if (!isc) {
          const int s = s0 + r;
          const int p0 = s >> 6, p1 = 128 + (s & 63);
          float cs = ropec[p0 * 16 + f], sn = ropes[p0 * 16 + f];
          float px = swz16(x0);
          x0 = hi ? (px * sn + x0 * cs) : (x0 * cs - px * sn);
          cs = ropec[p1 * 16 + f]; sn = ropes[p1 * 16 + f];
          px = swz16(x1);
          x1 = hi ? (px * sn + x1 * cs) : (x1 * cs - px * sn);
        }
        t0[i] = x0; t1[i] = x1;
        if ((i & 3) == 3) asm volatile("" ::: "memory");
      }
      u16* kbase = Kb + ((size_t)bh * 8448 + key0) * 192;
#pragma unroll
      for (int i = 0; i < 16; i += 2) {
#pragma unroll
        for (int nt = 0; nt < 4; ++nt) pair_store(kbase, 192, roff(i, g), nt * 32 + lr, acc[nt][i], acc[nt][i + 1], lane);
        pair_store(kbase, 192, roff(i, g), 128 + lr, t0[i], t0[i + 1], lane);
        pair_store(kbase, 192, roff(i, g), 160 + lr, t1[i], t1[i + 1], lane);
      }
    }
  }
};

struct EpRes {
  const float* srcL; const float* srcC; float* dstL; float* dstC; const float* gate;
  template <int NT>
  __device__ __forceinline__ void operator()(f32x16 (&acc)[NT], int mw, int n0, int lane) const {
    const int lr = lane & 31, g = lane >> 5;
    const bool lat = mw < T_LAT;
    const int mwl = lat ? mw : mw - T_LAT;
    const int gb = lat ? (mw >> 13) : 4;
    const __amdgpu_buffer_rsrc_t rsS = __builtin_amdgcn_make_buffer_rsrc((void*)(lat ? srcL : srcC), 0, 0x7fffffff, 0x00020000);
    const __amdgpu_buffer_rsrc_t rsD = __builtin_amdgcn_make_buffer_rsrc((void*)(lat ? dstL : dstC), 0, 0x7fffffff, 0x00020000);
    const int voff = (4 * g * 1024 + lr) * 4;
#pragma unroll
    for (int nt = 0; nt < NT; ++nt) {
      const int col = n0 + nt * 32 + lr;
      const float gv = gate[gb * 6144 + col];
#pragma unroll
      for (int i = 0; i < 16; ++i) {
        const int soff = ((mwl + (i & 3) + 8 * (i >> 2)) * 1024 + n0 + nt * 32) * 4;
        const float sv = __uint_as_float(__builtin_amdgcn_raw_buffer_load_b32(rsS, voff, soff, 0));
        __builtin_amdgcn_raw_buffer_store_b32(__float_as_uint(sv + gv * acc[nt][i]), rsD, voff, soff, 0);
      }
    }
  }
};

struct EpFfn1 {
  u16* hid;
  __device__ __forceinline__ void operator()(f32x16 (&acc)[4], int mw, int n0, int lane) const {
    const int lr = lane & 31, g = lane >> 5, odd = lane & 1;
    const __amdgpu_buffer_rsrc_t rs = __builtin_amdgcn_make_buffer_rsrc((void*)hid, 0, 0x7fffffff, 0x00020000);
    const int voff = ((4 * g + odd) * DFF + (((n0 >> 7) * 64 + lr) & ~1)) * 2;
#pragma unroll
    for (int nt = 0; nt < 2; ++nt) {
#pragma unroll
      for (int i = 0; i < 16; i += 2) {
        const float va = silu_f(acc[nt][i]) * acc[nt + 2][i], vb = silu_f(acc[nt][i + 1]) * acc[nt + 2][i + 1];
        const float na = dpp_f<0xB1>(va), nb = dpp_f<0xB1>(vb);
        const unsigned w = odd ? pack2(nb, vb) : pack2(va, na);
        const int soff = ((mw + (i & 3) + 8 * (i >> 2)) * DFF + nt * 32) * 2;
        __builtin_amdgcn_raw_buffer_store_b32(w, rs, voff, soff, 0);
      }
    }
  }
};

struct EpRw1 {
  u16* r; u16* k; u16* v; u16* hidw; u16* hida; u16* hidg;
  __device__ __forceinline__ void operator()(f32x16 (&acc)[4], int mw, int n0, int lane) const {
    const int lr = lane & 31, g = lane >> 5;
    u16* dst; int ld, c0, act;
    if (n0 < 1024) { dst = r; ld = 1024; c0 = n0; act = 0; }
    else if (n0 < 2048) { dst = k; ld = 1024; c0 = n0 - 1024; act = 0; }
    else if (n0 < 3072) { dst = v; ld = 1024; c0 = n0 - 2048; act = 0; }
    else if (n0 < 3200) { dst = hidw; ld = 128; c0 = 0; act = 1; }
    else if (n0 < 3328) { dst = hida; ld = 128; c0 = 0; act = 0; }
    else { dst = hidg; ld = 256; c0 = n0 - 3328; act = 2; }
    const int odd = lane & 1;
    const __amdgpu_buffer_rsrc_t rs = __builtin_amdgcn_make_buffer_rsrc((void*)dst, 0, 0x7fffffff, 0x00020000);
    const int voff = ((4 * g + odd) * ld + (lr & ~1)) * 2;
#pragma unroll
    for (int nt = 0; nt < 4; ++nt) {
#pragma unroll
      for (int i = 0; i < 16; i += 2) {
        float x = acc[nt][i], y = acc[nt][i + 1];
        if (act == 1) { x = tanh_f(x); y = tanh_f(y); } else if (act == 2) { x = sigmoid_f(x); y = sigmoid_f(y); }
        pair_store_b(rs, voff, ((mw + (i & 3) + 8 * (i >> 2)) * ld + c0 + nt * 32) * 2, x, y, odd);
      }
    }
  }
};

struct EpPlain {
  u16* dst; int ld;
  __device__ __forceinline__ void operator()(f32x16 (&acc)[4], int mw, int n0, int lane) const {
    const int lr = lane & 31, g = lane >> 5;
#pragma unroll
    for (int nt = 0; nt < 4; ++nt)
#pragma unroll
      for (int i = 0; i < 16; i += 2)
        pair_store(dst, ld, mw + roff(i, g), n0 + nt * 32 + lr, acc[nt][i], acc[nt][i + 1], lane);
  }
};

struct Job {
  const float* src; int ld, K, N; u16* dst; int Kpad, Npad, ldd, blk, rowstep, rowoff; const float* scale;
};
__device__ __forceinline__ Job mkjob(const float* src, int ld, int K, int N, u16* dst, int Kpad, int Npad, int ldd,
                                     int blk, int rowstep, int rowoff, const float* scale) {
  Job j; j.src = src; j.ld = ld; j.K = K; j.N = N; j.dst = dst; j.Kpad = Kpad; j.Npad = Npad; j.ldd = ldd;
  j.blk = blk; j.rowstep = rowstep; j.rowoff = rowoff; j.scale = scale; return j;
}
constexpr int NJOBS = 24;
__device__ __forceinline__ Job get_job(const Params& p, int j) {
  u16* W = (u16*)(wsp(p) + OFF_W);
  switch (j) {
    case 0: return mkjob(inp(p, 11), 704, 1024, 704, W + W_DQ, 1024, 704, 1024, 704, 0, 0, nullptr);
    case 1: return mkjob(inp(p, 14), 1536, 384, 1536, W + W_UQ, 384, 1536, 384, 1536, 0, 0, inp(p, 12));
    case 2: return mkjob(inp(p, 15), 2048, 256, 2048, W + W_UKV, 256, 2048, 256, 2048, 0, 0, inp(p, 13));
    case 3: return mkjob(inp(p, 18), 1024, 1024, 1024, W + W_O0, 1024, 1024, 1024, 1024, 0, 0, nullptr);
    case 4: return mkjob(inp(p, 8), DFF, 1024, DFF, W + W_13, 1024, DFF, 1024, 64, 128, 0, nullptr);
    case 5: return mkjob(inp(p, 9), DFF, 1024, DFF, W + W_13, 1024, DFF, 1024, 64, 128, 64, nullptr);
    case 6: return mkjob(inp(p, 10), 1024, DFF, 1024, W + W_2, DFF, 1024, DFF, 1024, 0, 0, nullptr);
    case 7: return mkjob(inp(p, 8) + 1024 * DFF, DFF, 1024, DFF, W + W_13 + W13_SZ, 1024, DFF, 1024, 64, 128, 0, nullptr);
    case 8: return mkjob(inp(p, 9) + 1024 * DFF, DFF, 1024, DFF, W + W_13 + W13_SZ, 1024, DFF, 1024, 64, 128, 64, nullptr);
    case 9: return mkjob(inp(p, 10) + 1024 * DFF, 1024, DFF, 1024, W + W_2 + W2_SZ, DFF, 1024, DFF, 1024, 0, 0, nullptr);
    case 10: return mkjob(inp(p, 20), 1024, 1024, 1024, W + W_P1, 1024, 1024, 1024, 1024, 0, 0, nullptr);
    case 11: return mkjob(inp(p, 21), 1024, 1024, 1024, W + W_P1, 1024, 1024, 1024, 1024, 0, 1024, nullptr);
    case 12: return mkjob(inp(p, 22), 1024, 1024, 1024, W + W_P1, 1024, 1024, 1024, 1024, 0, 2048, nullptr);
    case 13: return mkjob(inp(p, 28), 64, 1024, 64, W + W_P1, 1024, 64, 1024, 64, 0, 3072, nullptr);
    case 14: return mkjob(inp(p, 28) + 65536, 64, 1024, 64, W + W_P1, 1024, 64, 1024, 64, 0, 3136, nullptr);
    case 15: return mkjob(inp(p, 31), 64, 1024, 64, W + W_P1, 1024, 64, 1024, 64, 0, 3200, nullptr);
    case 16: return mkjob(inp(p, 31) + 65536, 64, 1024, 64, W + W_P1, 1024, 64, 1024, 64, 0, 3264, nullptr);
    case 17: return mkjob(inp(p, 33), 160, 1024, 160, W + W_P1, 1024, 256, 1024, 256, 0, 3328, nullptr);
    case 18: return mkjob(inp(p, 23), 1024, 1024, 1024, W + W_O1, 1024, 1024, 1024, 1024, 0, 0, nullptr);
    case 19: return mkjob(inp(p, 29), 1024, 64, 1024, W + W_DW2, 64, 1024, 64, 1024, 0, 0, nullptr);
    case 20: return mkjob(inp(p, 29) + 65536, 1024, 64, 1024, W + W_DW2 + 65536, 64, 1024, 64, 1024, 0, 0, nullptr);
    case 21: return mkjob(inp(p, 32), 1024, 64, 1024, W + W_IA2, 64, 1024, 64, 1024, 0, 0, nullptr);
    case 22: return mkjob(inp(p, 32) + 65536, 1024, 64, 1024, W + W_IA2 + 65536, 64, 1024, 64, 1024, 0, 0, nullptr);
    default: return mkjob(inp(p, 34), 1024, 160, 1024, W + W_G2, 192, 1024, 192, 1024, 0, 0, nullptr);
  }
}

__device__ __forceinline__ void transpose_tile(const Job& jb, int tile, char* smem, bool valid) {
  const int half = threadIdx.x >> 8, tid = threadIdx.x & 255;
  float* ts = (float*)smem + half * (64 * 65);
  const int nkt = jb.Kpad >> 6;
  const int kt = tile % nkt, nt = tile / nkt;
  __syncthreads();
  if (valid) {
    const int col = tid & 63, rb = tid >> 6;
    const int n = nt * 64 + col;
#pragma unroll 4
    for (int i = 0; i < 16; ++i) {
      const int kk = rb + 4 * i, k = kt * 64 + kk;
      float v = 0.f;
      if (k < jb.K && n < jb.N) { v = jb.src[(size_t)k * jb.ld + n]; if (jb.scale) v *= jb.scale[k]; }
      ts[kk * 65 + col] = v;
    }
  }
  __syncthreads();
  if (valid) {
    const int nl = tid >> 2, kc = (tid & 3) * 16;
    const int n = nt * 64 + nl;
    const int drow = (n / jb.blk) * jb.rowstep + jb.rowoff + (n % jb.blk);
    unsigned w[8];
#pragma unroll
    for (int j = 0; j < 8; ++j) w[j] = pack2(ts[(kc + 2 * j) * 65 + nl], ts[(kc + 2 * j + 1) * 65 + nl]);
    uint4* d = (uint4*)(jb.dst + (size_t)drow * jb.ldd + kt * 64 + kc);
    d[0] = make_uint4(w[0], w[1], w[2], w[3]);
    d[1] = make_uint4(w[4], w[5], w[6], w[7]);
  }
}

__device__ __forceinline__ void mods_task(const Params& p, int task, char* smem) {
  float* sc = (float*)smem;
  float* part = sc + 5 * 1024;
  const int layer = task / 96, j0 = (task % 96) * 64;
  const int tid = threadIdx.x;
  __syncthreads();
  for (int i = tid; i < 5 * 1024; i += 512) {
    const int r = i >> 10, k = i & 1023;
    const float cv = (r < 4) ? inp(p, 1)[r * 1024 + k] : inp(p, 3)[k];
    sc[i] = silu_f(cv);
  }
  __syncthreads();
  const int col = tid & 63, kp = tid >> 6;
  const float* w = inp(p, 4) + (size_t)layer * 1024 * 6144 + j0 + col;
  float a[5] = {0.f, 0.f, 0.f, 0.f, 0.f};
#pragma unroll 8
  for (int k = kp * 128; k < kp * 128 + 128; ++k) {
    const float wv = w[(size_t)k * 6144];
#pragma unroll
    for (int r = 0; r < 5; ++r) a[r] += sc[r * 1024 + k] * wv;
  }
#pragma unroll
  for (int r = 0; r < 5; ++r) part[(kp * 5 + r) * 64 + col] = a[r];
  __syncthreads();
  for (int i = tid; i < 320; i += 512) {
    const int r = i >> 6, c = i & 63;
    float s = 0.f;
#pragma unroll
    for (int q = 0; q < 8; ++q) s += part[(q * 5 + r) * 64 + c];
    float* mod = (float*)(wsp(p) + OFF_MOD);
    mod[(layer * 5 + r) * 6144 + j0 + c] = s + inp(p, 5)[layer * 6144 + j0 + c];
  }
}

__device__ __forceinline__ void rope_task(const Params& p) {
  const float invf[16] = {1.000000000e+00f, 5.623413324e-01f, 3.162277639e-01f, 1.778279394e-01f, 1.000000015e-01f,
                          5.623413250e-02f, 3.162277490e-02f, 1.778279431e-02f, 9.999999776e-03f, 5.623413250e-03f,
                          3.162277630e-03f, 1.778279431e-03f, 1.000000047e-03f, 5.623413017e-04f, 3.162277571e-04f,
                          1.778279402e-04f};
  float* rc = (float*)(wsp(p) + OFF_ROPE);
  float* rsn = rc + 192 * 16;
  for (int i = threadIdx.x; i < 192 * 16; i += 512) {
    const int pi = i >> 4, f = i & 15;
    const int pos = pi < 128 ? pi : pi - 128;
    float fi = 1.f;
#pragma unroll
    for (int q = 0; q < 16; ++q) if (q == f) fi = invf[q];
    const float ang = (float)pos * fi;
    const double a = (double)ang;
    const double n = rint(a * 0.15915494309189535);
    const double r = a - n * 6.283185307179586476925;
    const double x = r * 0.25, x2 = x * x;
    const double sn = x * (1.0 + x2 * (-1.0 / 6 + x2 * (1.0 / 120 + x2 * (-1.0 / 5040 + x2 * (1.0 / 362880 + x2 * (-1.0 / 39916800 + x2 * (1.0 / 6227020800.0)))))));
    const double cs = 1.0 + x2 * (-0.5 + x2 * (1.0 / 24 + x2 * (-1.0 / 720 + x2 * (1.0 / 40320 + x2 * (-1.0 / 3628800 + x2 * (1.0 / 479001600.0 + x2 * (-1.0 / 87178291200.0)))))));
    const double s2 = 2 * sn * cs, c2 = cs * cs - sn * sn;
    rsn[i] = (float)(2 * s2 * c2);
    rc[i] = (float)(c2 * c2 - s2 * s2);
  }
}

__device__ __forceinline__ void phase_prep(const Params& p, char* smem) {
  int total = 0;
  for (int j = 0; j < NJOBS; ++j) { Job jb = get_job(p, j); total += (jb.Kpad >> 6) * (jb.Npad >> 6); }
  const int npair = (total + 1) >> 1;
  const int ntask = npair + 192 + 1;
  const int half = threadIdx.x >> 8;
  for (int t = blockIdx.x; t < ntask; t += gridDim.x) {
    if (t < npair) {
      int rem = 2 * t + half;
      const bool valid = rem < total;
      if (!valid) rem = total - 1;
      Job jb = get_job(p, 0);
      for (int j = 0; j < NJOBS; ++j) {
        jb = get_job(p, j);
        const int nt = (jb.Kpad >> 6) * (jb.Npad >> 6);
        if (rem < nt) break;
        rem -= nt;
      }
      transpose_tile(jb, rem, smem, valid);
    } else if (t < npair + 192) {
      mods_task(p, t - npair, smem);
    } else {
      rope_task(p);
    }
  }
}

__device__ __forceinline__ void load_row16(const float* row, int lane, float (&v)[16]) {
#pragma unroll
  for (int j = 0; j < 4; ++j) {
    const float4 f = *(const float4*)(row + j * 256 + lane * 4);
    v[4 * j] = f.x; v[4 * j + 1] = f.y; v[4 * j + 2] = f.z; v[4 * j + 3] = f.w;
  }
}
__device__ __forceinline__ void norm_mod16(float (&v)[16], const float* gn, const float* sh, const float* sc, int lane) {
  float ss = 0.f;
#pragma unroll
  for (int j = 0; j < 16; ++j) ss += v[j] * v[j];
  ss = red64(ss);
  const float rstd = rsqrtf(ss * (1.f / 1024.f) + 1e-6f);
#pragma unroll
  for (int j = 0; j < 4; ++j) {
    const int col = j * 256 + lane * 4;
    const float4 gv = *(const float4*)(gn + col), sv = *(const float4*)(sh + col), cv = *(const float4*)(sc + col);
    v[4 * j + 0] = v[4 * j + 0] * rstd * gv.x * (1.f + cv.x) + sv.x;
    v[4 * j + 1] = v[4 * j + 1] * rstd * gv.y * (1.f + cv.y) + sv.y;
    v[4 * j + 2] = v[4 * j + 2] * rstd * gv.z * (1.f + cv.z) + sv.z;
    v[4 * j + 3] = v[4 * j + 3] * rstd * gv.w * (1.f + cv.w) + sv.w;
  }
}
__device__ __forceinline__ void store_row16(u16* row, int lane, const float (&v)[16]) {
#pragma unroll
  for (int j = 0; j < 4; ++j) {
    uint2 w; w.x = pack2(v[4 * j], v[4 * j + 1]); w.y = pack2(v[4 * j + 2], v[4 * j + 3]);
    *(uint2*)(row + j * 256 + lane * 4) = w;
  }
}

__device__ __forceinline__ void phase_norm(const Params& p, int which) {
  const int lane = threadIdx.x & 63, wid = threadIdx.x >> 6;
  const int nrows = (which == 3) ? T_LAT : T_ALL;
  const int layer = (which == 3) ? 1 : 0;
  const float* mod = (const float*)(wsp(p) + OFF_MOD) + layer * 5 * 6144;
  const float* gn = (which == 0) ? inp(p, 6) : (inp(p, 7) + layer * 1024);
  const int shi = (which == 0) ? 0 : 3;
  const float* srcL = (which == 0) ? inp(p, 0) : outp(p);
  const float* srcC = (which == 0) ? inp(p, 2) : (const float*)(wsp(p) + OFF_CTXR);
  u16* dst = (u16*)(wsp(p) + ((which == 1) ? OFF_F : OFF_A));
  for (int t = blockIdx.x * 8 + wid; t < nrows; t += gridDim.x * 8) {
    const float* src; int gb;
    if (t < T_LAT) { src = srcL + (size_t)t * 1024; gb = t >> 13; } else { src = srcC + (size_t)(t - T_LAT) * 1024; gb = 4; }
    float v[16];
    load_row16(src, lane, v);
    norm_mod16(v, gn, mod + gb * 6144 + shi * 1024, mod + gb * 6144 + (shi + 1) * 1024, lane);
    store_row16(dst + (size_t)t * 1024, lane, v);
  }
}

__device__ __forceinline__ void phase_norm_shift(const Params& p) {
  const int lane = threadIdx.x & 63, wid = threadIdx.x >> 6;
  const float* mod = (const float*)(wsp(p) + OFF_MOD) + 5 * 6144;
  const float* gn = inp(p, 6) + 1024;
  u16* h1 = (u16*)(wsp(p) + OFF_A);
  u16* xx = (u16*)(wsp(p) + OFF_B);
  for (int t = blockIdx.x * 8 + wid; t < T_ALL; t += gridDim.x * 8) {
    const float* src; int gb, s, L;
    if (t < T_LAT) { src = outp(p) + (size_t)t * 1024; gb = t >> 13; s = t & 8191; L = 8192; }
    else { src = (const float*)(wsp(p) + OFF_CTXR) + (size_t)(t - T_LAT) * 1024; gb = 4; s = (t - T_LAT) & 255; L = 256; }
    const float* sh = mod + gb * 6144; const float* sc = sh + 1024;
    float v[16], a[16], b[16];
    load_row16(src, lane, v);
    norm_mod16(v, gn, sh, sc, lane);
    if (s > 0) { load_row16(src - 1024, lane, a); norm_mod16(a, gn, sh, sc, lane); }
    else {
#pragma unroll
      for (int j = 0; j < 16; ++j) a[j] = 0.f;
    }
    if (s < L - 1) { load_row16(src + 1024, lane, b); norm_mod16(b, gn, sh, sc, lane); }
    else {
#pragma unroll
      for (int j = 0; j < 16; ++j) b[j] = 0.f;
    }
#pragma unroll
    for (int j = 0; j < 16; ++j) a[j] = 0.5f * (a[j] + b[j]) - v[j];
    store_row16(h1 + (size_t)t * 1024, lane, v);
    store_row16(xx + (size_t)t * 1024, lane, a);
  }
}

__device__ __forceinline__ void attn_task(const Params& p, char* smem, int task) {
  const int tid = threadIdx.x, lane = tid & 63, wid = tid >> 6, lr = lane & 31, g = lane >> 5;
  const u16* Ql = (const u16*)(wsp(p) + OFF_C);
  const u16* Qc = Ql + (size_t)32 * 8192 * 192;
  const u16* Kb = (const u16*)(wsp(p) + OFF_C + 99 * MiB);
  const u16* Vt = (const u16*)(wsp(p) + OFF_B);
  u16* AO = (u16*)(wsp(p) + OFF_A);
  int bh, nkt; const u16* Qp; size_t tok0;
  if (task < 1024) { bh = task >> 5; const int q0 = (task & 31) * 256; nkt = 264; Qp = Ql + ((size_t)bh * 8192 + q0) * 192; tok0 = (size_t)(bh >> 3) * 8192 + q0; }
  else { bh = task - 1024; nkt = 8; Qp = Qc + (size_t)bh * 256 * 192; tok0 = (size_t)T_LAT + (bh >> 3) * 256; }
  const u16* Kp = Kb + (size_t)bh * 8448 * 192;
  const u16* Vp = Vt + (size_t)bh * 128 * 8448;
  bf16x8 qf[12];
#pragma unroll
  for (int ks = 0; ks < 12; ++ks) qf[ks] = *(const bf16x8*)(Qp + (size_t)(wid * 32 + lr) * 192 + ks * 16 + g * 8);
  f32x16 O[4];
#pragma unroll
  for (int dt = 0; dt < 4; ++dt)
#pragma unroll
    for (int i = 0; i < 16; ++i) O[dt][i] = 0.f;
  float m = -1e30f, l = 0.f;
  constexpr int KBYTES = 32 * 384, ASTAGE = KBYTES + 128 * 64;
  const int wu = __builtin_amdgcn_readfirstlane(wid);
  const bool kwave = wu < 4;
  unsigned gp[3];
  const __amdgpu_buffer_rsrc_t rsKV = __builtin_amdgcn_make_buffer_rsrc((void*)(kwave ? Kp : Vp), 0, 0x7fffffff, 0x00020000);
#pragma unroll
  for (int i = 0; i < 3; ++i) {
    if (kwave) {
      const int o = (i * 4 + wu) * 1024 + lane * 16;
      const int row = o / 384, pos = (o - row * 384) >> 4;
      const int c = (pos & ~7) | ((pos & 7) ^ ((row >> 1) & 7));
      gp[i] = (unsigned)(row * 192 + c * 8) * 2u;
    } else {
      const int row = ((i & 1) * 4 + (wu - 4)) * 16 + (lane >> 2);
      const int c = (lane & 3) ^ ((row >> 2) & 3);
      gp[i] = (unsigned)(row * 8448 + c * 8) * 2u;
    }
  }
#define ATT_STAGE(BUF, J)                                                                                            \
  {                                                                                                                  \
    if (kwave) {                                                                                                     \
      _Pragma("unroll") for (int i = 0; i < 3; ++i) __builtin_amdgcn_raw_ptr_buffer_load_lds(                        \
          rsKV, (LAS void*)(smem + (BUF) * ASTAGE + (i * 4 + wu) * 1024), 16, gp[i], (J) * (32 * 192 * 2), 0, 0);    \
    } else {                                                                                                         \
      _Pragma("unroll") for (int i = 0; i < 2; ++i) __builtin_amdgcn_raw_ptr_buffer_load_lds(                        \
          rsKV, (LAS void*)(smem + (BUF) * ASTAGE + KBYTES + (i * 4 + wu - 4) * 1024), 16, gp[i], (J) * 64, 0, 0);   \
    }                                                                                                                \
  }
  const int ksw = (lr >> 1) & 7, vsw = (lr >> 2) & 3;
  WAIT_V(0);
  __syncthreads();
  ATT_STAGE(0, 0)
  if (nkt > 1) ATT_STAGE(1, 1)
  int cur = 0, nxt = 2;
  for (int j = 0; j < nkt; ++j) {
    if (j + 1 < nkt) { if (kwave) WAIT_V(3); else WAIT_V(2); } else WAIT_V(0);
    lds_barrier();
    if (j + 2 < nkt) ATT_STAGE(nxt, j + 2)
    const char* Kc = smem + cur * ASTAGE;
    const char* Vc = Kc + KBYTES;
    cur = (cur == 2) ? 0 : cur + 1;
    nxt = (nxt == 2) ? 0 : nxt + 1;
    f32x16 s0;
#pragma unroll
    for (int i = 0; i < 16; ++i) s0[i] = 0.f;
#pragma unroll
    for (int ks = 0; ks < 12; ++ks) {
      const int kc = ks * 2 + g;
      bf16x8 a0 = *(const bf16x8*)(Kc + lr * 384 + (((kc & ~7) | ((kc & 7) ^ ksw)) << 4));
      s0 = mfma32(a0, qf[ks], s0);
    }
    if ((j & 3) == 0) {
      float mx = s0[0];
#pragma unroll
      for (int i = 1; i < 16; ++i) mx = fmaxf(mx, s0[i]);
      mx = max_x32(mx);
      if (__builtin_amdgcn_ballot_w64(mx > m + 8.0f) != 0ull) {
        const float mn = fmaxf(m, mx);
        const float alpha = __builtin_amdgcn_exp2f(m - mn);
        m = mn;
        l *= alpha;
#pragma unroll
        for (int dt = 0; dt < 4; ++dt)
#pragma unroll
          for (int i = 0; i < 16; ++i) O[dt][i] *= alpha;
      }
    }
    float ps = 0.f;
#pragma unroll
    for (int i = 0; i < 16; ++i) { s0[i] = __builtin_amdgcn_exp2f(s0[i] - m); ps += s0[i]; }
    l += ps;
    bf16x8 pf[2];
    {
      u32x4 w;
      w[0] = pack2(s0[0], s0[1]); w[1] = pack2(s0[2], s0[3]); w[2] = pack2(s0[4], s0[5]); w[3] = pack2(s0[6], s0[7]);
      pf[0] = __builtin_bit_cast(bf16x8, w);
      w[0] = pack2(s0[8], s0[9]); w[1] = pack2(s0[10], s0[11]); w[2] = pack2(s0[12], s0[13]); w[3] = pack2(s0[14], s0[15]);
      pf[1] = __builtin_bit_cast(bf16x8, w);
    }
#pragma unroll
    for (int dt = 0; dt < 4; ++dt) {
#pragma unroll
      for (int kk = 0; kk < 2; ++kk) {
        bf16x8 vf = *(const bf16x8*)(Vc + (dt * 32 + lr) * 64 + (((kk * 2 + g) ^ vsw) << 4));
        O[dt] = mfma32(vf, pf[kk], O[dt]);
      }
    }
  }
#undef ATT_STAGE
  l += __shfl_xor(l, 32);
  const float inv = 1.f / l;
  {
    const __amdgpu_buffer_rsrc_t rsO = __builtin_amdgcn_make_buffer_rsrc((void*)AO, 0, 0x7fffffff, 0x00020000);
    const int voff = (lr * 1024 + 4 * g) * 2;
    const int sbase = ((int)(tok0 + wu * 32) * 1024 + (bh & 7) * 128) * 2;
#pragma unroll
    for (int dt = 0; dt < 4; ++dt)
#pragma unroll
      for (int a2 = 0; a2 < 4; ++a2) {
        typedef unsigned u32x2 __attribute__((ext_vector_type(2)));
        u32x2 w;
        w[0] = pack2(O[dt][4 * a2] * inv, O[dt][4 * a2 + 1] * inv);
        w[1] = pack2(O[dt][4 * a2 + 2] * inv, O[dt][4 * a2 + 3] * inv);
        __builtin_amdgcn_raw_buffer_store_b64(w, rsO, voff, sbase + (dt * 32 + 8 * a2) * 2, 0);
      }
  }
}

template <int LPR>
__device__ __forceinline__ float red_lpr(float v) {
  if (LPR == 16) return red16(v);
  return red8(v);
}

template <int LPR>
__device__ __forceinline__ void scan_task(const Params& p, char* smem, int task) {
  constexpr int ROWS = 512 / LPR, EPT = 64 / LPR, NSPLIT = 64 / ROWS;
  constexpr int NST = 32;
  constexpr int NYK = NST / LPR;
  float* Wd = (float*)smem;
  float* KD = Wd + NST * 64; float* AA = KD + NST * 64; float* BB = AA + NST * 64; float* RR = BB + NST * 64;
  float* VV = RR + NST * 64; float* AS = VV + NST * 64; float* YO = AS + NST * 64;
  const int chain = task / NSPLIT, hv = task % NSPLIT;
  const int d = chain & 1, bh = chain >> 1, b = bh >> 4, h = bh & 15;
  const int tid = threadIdx.x, lane = tid & 63;
  const int wid = __builtin_amdgcn_readfirstlane(tid >> 6);
  const int msel = wid & 1, ntb = wid >> 1;
  const u16* W = (const u16*)(wsp(p) + OFF_W);
  const u16* rbuf = (const u16*)(wsp(p) + OFF_C);
  const u16* kbuf = rbuf + (size_t)T_ALL * 1024;
  const u16* vbuf = kbuf + (size_t)T_ALL * 1024;
  const u16* hidw = (const u16*)(wsp(p) + OFF_E);
  const u16* hida = hidw + (size_t)T_ALL * 128;
  u16* ybuf = (u16*)(wsp(p) + (d ? OFF_B : OFF_A));
  float* bonus = (float*)(wsp(p) + OFF_BONUS) + (size_t)d * T_LAT * 16;
  bf16x8 wb[1][2];
  float biasv[1];
  const u16* hid = msel ? hida : hidw;
  {
    const u16* W2 = W + (msel ? W_IA2 : W_DW2) + (size_t)d * 65536;
    const float* bias = (msel ? inp(p, 30) : inp(p, 27)) + d * 1024;
#pragma unroll
    for (int n2 = 0; n2 < 1; ++n2) {
#pragma unroll
      for (int ks = 0; ks < 2; ++ks)
        wb[n2][ks] = *(const bf16x8*)(W2 + (size_t)(h * 64 + (ntb + n2) * 16 + (lane & 15)) * 64 + ks * 32 + (lane >> 4) * 8);
      biasv[n2] = bias[h * 64 + (ntb + n2) * 16 + (lane & 15)];
    }
  }
  const int st2 = tid >> 4, c4 = (tid & 15) * 4;
  float* CK = YO + NST * ROWS * LPR;
  if (tid < 192) {
    const int which = tid >> 6, ch = tid & 63;
    const float* src = (which == 0) ? inp(p, 24) : (which == 1) ? inp(p, 25) : inp(p, 26);
    CK[tid] = src[h * 64 + ch];
  }
  const int vrow = tid / LPR, part = tid % LPR;
  float S[EPT];
#pragma unroll
  for (int j = 0; j < EPT; ++j) S[j] = 0.f;
  auto tok = [&](int i) -> int {
    if (i < 256) return T_LAT + b * 256 + (d ? 255 - i : i);
    const int s = i - 256;
    return b * 8192 + (d ? 8191 - s : s);
  };
  bf16x8 na[2][2]; uint2 nk1, nv1, nr1;
  auto prefetch = [&](int i0) {
#pragma unroll
    for (int hf = 0; hf < 2; ++hf) {
      const int t = tok(i0 + hf * 16 + (lane & 15));
#pragma unroll
      for (int ks = 0; ks < 2; ++ks) na[hf][ks] = *(const bf16x8*)(hid + (size_t)t * 128 + d * 64 + ks * 32 + (lane >> 4) * 8);
    }
    const int t2 = tok(i0 + st2);
    const size_t o = (size_t)t2 * 1024 + h * 64 + c4;
    nk1 = *(const uint2*)(kbuf + o); nv1 = *(const uint2*)(vbuf + o); nr1 = *(const uint2*)(rbuf + o);
  };
  prefetch(0);
  __syncthreads();
  constexpr int NSTG = 8448 / NST;
  for (int stg = 0; stg < NSTG; ++stg) {
    const int i0 = stg * NST;
    {
      float* dstp = msel ? AS : Wd;
#pragma unroll
      for (int hf = 0; hf < 2; ++hf) {
        f32x4 acc[1];
#pragma unroll
        for (int n2 = 0; n2 < 1; ++n2) { acc[n2][0] = 0.f; acc[n2][1] = 0.f; acc[n2][2] = 0.f; acc[n2][3] = 0.f; }
#pragma unroll
        for (int ks = 0; ks < 2; ++ks)
#pragma unroll
          for (int n2 = 0; n2 < 1; ++n2) acc[n2] = mfma16(na[hf][ks], wb[n2][ks], acc[n2]);
#pragma unroll
        for (int n2 = 0; n2 < 1; ++n2)
#pragma unroll
          for (int i = 0; i < 4; ++i) {
            const int step = hf * 16 + (lane >> 4) * 4 + i, ch = (ntb + n2) * 16 + (lane & 15);
            const float sg = sigmoid_f(acc[n2][i] + biasv[n2]);
            dstp[step * 64 + ch] = msel ? sg : __expf(-0.6065306597126334f * sg);
          }
      }
    }
    lds_barrier();
    {
      const int stp = st2;
      const int t2 = tok(i0 + stp);
      float kr[4] = {lo2f(nk1.x), hi2f(nk1.x), lo2f(nk1.y), hi2f(nk1.y)};
      float vr[4] = {lo2f(nv1.x), hi2f(nv1.x), lo2f(nv1.y), hi2f(nv1.y)};
      float rr[4] = {lo2f(nr1.x), hi2f(nr1.x), lo2f(nr1.y), hi2f(nr1.y)};
      const float4 av = *(const float4*)(AS + stp * 64 + c4);
      float a[4] = {av.x, av.y, av.z, av.w};
      const float4 c0 = *(const float4*)(CK + c4), c1 = *(const float4*)(CK + 64 + c4), c2 = *(const float4*)(CK + 128 + c4);
      const float kkc[4] = {c0.x, c0.y, c0.z, c0.w}, kac[4] = {c1.x, c1.y, c1.z, c1.w}, rkc[4] = {c2.x, c2.y, c2.z, c2.w};
      float kk[4], ss = 0.f;
#pragma unroll
      for (int j = 0; j < 4; ++j) { kk[j] = kr[j] * kkc[j]; ss += kk[j] * kk[j]; }
      ss = red16(ss);
      const float inv = rsqrtf(ss + 1e-12f);
      float bon = 0.f;
      float o_aa[4], o_bb[4], o_kd[4];
#pragma unroll
      for (int j = 0; j < 4; ++j) {
        const float kn = kk[j] * inv;
        o_aa[j] = -kn; o_bb[j] = kn * a[j];
        o_kd[j] = kr[j] * (1.f + (a[j] - 1.f) * kac[j]);
        bon += rr[j] * o_kd[j] * rkc[j];
      }
      bon = red16(bon);
      *(float4*)(AA + stp * 64 + c4) = make_float4(o_aa[0], o_aa[1], o_aa[2], o_aa[3]);
      *(float4*)(BB + stp * 64 + c4) = make_float4(o_bb[0], o_bb[1], o_bb[2], o_bb[3]);
      *(float4*)(KD + stp * 64 + c4) = make_float4(o_kd[0], o_kd[1], o_kd[2], o_kd[3]);
      *(float4*)(RR + stp * 64 + c4) = make_float4(rr[0], rr[1], rr[2], rr[3]);
      *(float4*)(VV + stp * 64 + c4) = make_float4(vr[0], vr[1], vr[2], vr[3]);
      if ((tid & 15) == 0 && hv == 0 && t2 < T_LAT) bonus[(size_t)t2 * 16 + h] = bon;
    }
    lds_barrier();
    if (stg + 1 < NSTG) prefetch(i0 + NST);
    float xa[EPT], xw[EPT], xb[EPT], xk[EPT], xr[EPT], xv;
    float za[EPT], zw[EPT], zb[EPT], zk[EPT], zr[EPT], zv;
    float yk[NYK];
#pragma unroll
    for (int q = 0; q < NYK; ++q) yk[q] = 0.f;
#define SCAN_LD(ST, XA, XW, XB, XK, XR, XV)                                     \
    {                                                                            \
      _Pragma("unroll") for (int q = 0; q < EPT / 4; ++q) {                      \
        const float4 t0 = *(const float4*)(AA + (ST) * 64 + part * EPT + 4 * q); \
        const float4 t1 = *(const float4*)(Wd + (ST) * 64 + part * EPT + 4 * q); \
        const float4 t2 = *(const float4*)(BB + (ST) * 64 + part * EPT + 4 * q); \
        const float4 t3 = *(const float4*)(KD + (ST) * 64 + part * EPT + 4 * q); \
        const float4 t4 = *(const float4*)(RR + (ST) * 64 + part * EPT + 4 * q); \
        XA[4 * q] = t0.x; XA[4 * q + 1] = t0.y; XA[4 * q + 2] = t0.z; XA[4 * q + 3] = t0.w; \
        XW[4 * q] = t1.x; XW[4 * q + 1] = t1.y; XW[4 * q + 2] = t1.z; XW[4 * q + 3] = t1.w; \
        XB[4 * q] = t2.x; XB[4 * q + 1] = t2.y; XB[4 * q + 2] = t2.z; XB[4 * q + 3] = t2.w; \
        XK[4 * q] = t3.x; XK[4 * q + 1] = t3.y; XK[4 * q + 2] = t3.z; XK[4 * q + 3] = t3.w; \
        XR[4 * q] = t4.x; XR[4 * q + 1] = t4.y; XR[4 * q + 2] = t4.z; XR[4 * q + 3] = t4.w; \
      }                                                                          \
      XV = VV[(ST) * 64 + hv * ROWS + vrow];                                     \
    }
#define SCAN_STEP(ST, XA, XW, XB, XK, XR, XV)                                    \
    {                                                                            \
      float pr_[EPT], sw_[EPT];                                                  \
      _Pragma("unroll") for (int j = 0; j < EPT; ++j) { pr_[j] = S[j] * XA[j]; sw_[j] = S[j] * XW[j] + XV * XK[j]; } \
      _Pragma("unroll") for (int w_ = EPT / 2; w_ >= 1; w_ >>= 1)               \
        _Pragma("unroll") for (int j = 0; j < w_; ++j) pr_[j] += pr_[j + w_];    \
      const float sa = red_lpr<LPR>(pr_[0]);                                     \
      _Pragma("unroll") for (int j = 0; j < EPT; ++j) { S[j] = sa * XB[j] + sw_[j]; pr_[j] = S[j] * XR[j]; } \
      _Pragma("unroll") for (int w_ = EPT / 2; w_ >= 1; w_ >>= 1)               \
        _Pragma("unroll") for (int j = 0; j < w_; ++j) pr_[j] += pr_[j + w_];    \
      YO[((ST) * ROWS + vrow) * LPR + part] = pr_[0];                            \
    }
    SCAN_LD(0, xa, xw, xb, xk, xr, xv)
#pragma unroll 4
    for (int st = 0; st < NST; st += 2) {
      SCAN_LD(st + 1, za, zw, zb, zk, zr, zv)
      SCAN_STEP(st, xa, xw, xb, xk, xr, xv)
      if (st + 2 < NST) SCAN_LD(st + 2, xa, xw, xb, xk, xr, xv)
      SCAN_STEP(st + 1, za, zw, zb, zk, zr, zv)
    }
#undef SCAN_LD
#undef SCAN_STEP
    lds_barrier();
    if (i0 >= 256) {
      for (int e = tid; e < NST * ROWS / 2; e += 512) {
        const int st = e / (ROWS / 2), pr = (e % (ROWS / 2)) * 2;
        const int t = tok(i0 + st);
        float ysum[2];
#pragma unroll
        for (int u = 0; u < 2; ++u) {
          const float* yp = YO + (st * ROWS + pr + u) * LPR;
          float acc_ = 0.f;
#pragma unroll
          for (int q = 0; q < LPR / 4; ++q) { const float4 f = *(const float4*)(yp + 4 * q); acc_ += (f.x + f.y) + (f.z + f.w); }
          ysum[u] = acc_;
        }
        *(unsigned*)(ybuf + (size_t)t * 1024 + h * 64 + hv * ROWS + pr) = pack2(ysum[0], ysum[1]);
      }
    }
  }
}

__device__ __forceinline__ void phase_rwkv_out(const Params& p) {
  const int lane = threadIdx.x & 63, wid = threadIdx.x >> 6;
  const u16* yf = (const u16*)(wsp(p) + OFF_A);
  const u16* yb = (const u16*)(wsp(p) + OFF_B);
  const u16* vbuf = (const u16*)(wsp(p) + OFF_C) + (size_t)2 * T_ALL * 1024;
  const u16* gbuf = (const u16*)(wsp(p) + OFF_F);
  const float* bonus = (const float*)(wsp(p) + OFF_BONUS);
  u16* oin = (u16*)(wsp(p) + OFF_C);
  const int ch0 = lane * 16, head = lane >> 2;
  float gw[16], gb[16];
#pragma unroll
  for (int j = 0; j < 16; ++j) { gw[j] = inp(p, 35)[ch0 + j]; gb[j] = inp(p, 36)[ch0 + j]; }
  for (int t = blockIdx.x * 8 + wid; t < T_LAT; t += gridDim.x * 8) {
    const size_t o = (size_t)t * 1024 + ch0;
    uint4 a0 = *(const uint4*)(yf + o), a1 = *(const uint4*)(yf + o + 8);
    uint4 b0 = *(const uint4*)(yb + o), b1 = *(const uint4*)(yb + o + 8);
    uint4 v0 = *(const uint4*)(vbuf + o), v1 = *(const uint4*)(vbuf + o + 8);
    uint4 g0 = *(const uint4*)(gbuf + o), g1 = *(const uint4*)(gbuf + o + 8);
    const unsigned ya[8] = {a0.x, a0.y, a0.z, a0.w, a1.x, a1.y, a1.z, a1.w};
    const unsigned yb8[8] = {b0.x, b0.y, b0.z, b0.w, b1.x, b1.y, b1.z, b1.w};
    const unsigned vv[8] = {v0.x, v0.y, v0.z, v0.w, v1.x, v1.y, v1.z, v1.w};
    const unsigned gg[8] = {g0.x, g0.y, g0.z, g0.w, g1.x, g1.y, g1.z, g1.w};
    float y[16];
    float s = 0.f;
#pragma unroll
    for (int j = 0; j < 8; ++j) { y[2 * j] = lo2f(ya[j]) + lo2f(yb8[j]); y[2 * j + 1] = hi2f(ya[j]) + hi2f(yb8[j]); s += y[2 * j] + y[2 * j + 1]; }
    s = red4(s);
    const float mu = s * (1.f / 64.f);
    float q = 0.f;
#pragma unroll
    for (int j = 0; j < 16; ++j) { const float dlt = y[j] - mu; q += dlt * dlt; }
    q = red4(q);
    const float rstd = rsqrtf(q * (1.f / 64.f) + 64e-5f);
    const float bon = bonus[(size_t)t * 16 + head] + bonus[(size_t)T_LAT * 16 + (size_t)t * 16 + head];
    unsigned w[8];
#pragma unroll
    for (int j = 0; j < 8; ++j) {
      const float o0 = ((y[2 * j] - mu) * rstd * gw[2 * j] + gb[2 * j] + bon * lo2f(vv[j])) * lo2f(gg[j]);
      const float o1 = ((y[2 * j + 1] - mu) * rstd * gw[2 * j + 1] + gb[2 * j + 1] + bon * hi2f(vv[j])) * hi2f(gg[j]);
      w[j] = pack2(o0, o1);
    }
    *(uint4*)(oin + o) = make_uint4(w[0], w[1], w[2], w[3]);
    *(uint4*)(oin + o + 8) = make_uint4(w[4], w[5], w[6], w[7]);
  }
}

__device__ __forceinline__ void tile_map(int t, int total, int ntn, int& mt, int& nt) {
  const int q = total >> 3, r8 = total & 7, xcd = t & 7, off = t >> 3;
  const int v = (xcd < r8 ? xcd * (q + 1) : r8 * (q + 1) + (xcd - r8) * q) + off;
  const int pw = 4 * ntn;
  const int panel = v / pw, r = v - panel * pw;
  nt = r >> 2;
  mt = panel * 4 + (r & 3);
}

#define XB_TMO      128
#define XB_XCNT(j)  (256  + 64 * (j))
#define XB_XSUB(j)  (1280 + 64 * (j))
#define XB_XGEN(j)  (2304 + 64 * (j))
#define XB_TOP      3328
#define XB_TOPGEN   3392
#define XCD_BAR_WORDS 3456
#define XB_SPIN_CAP (1u << 20)
__device__ __forceinline__ unsigned xb_ld(unsigned* p) { return __hip_atomic_load(p, __ATOMIC_RELAXED, __HIP_MEMORY_SCOPE_AGENT); }
__device__ __forceinline__ unsigned xb_add(unsigned* p, unsigned v) { return __hip_atomic_fetch_add(p, v, __ATOMIC_RELAXED, __HIP_MEMORY_SCOPE_AGENT); }
__device__ __forceinline__ unsigned xb_xcc_id() { return (unsigned)__builtin_amdgcn_s_getreg((3 << 11) | 20) & 0xFu; }
#define XB_SPIN(cond, bar) do { unsigned _sp = 0; while (cond) { __builtin_amdgcn_s_sleep(1); \
    if ((++_sp & 255u) == 0u) { if (xb_ld(&(bar)[XB_TMO])) break; if (_sp > XB_SPIN_CAP) { atomicAdd(&(bar)[XB_TMO], 1u); break; } } } } while (0)
struct XcdBarrier { unsigned* bar; unsigned x; volatile LAS unsigned* st; };
__device__ __forceinline__ XcdBarrier xcd_barrier_post(unsigned* bar, volatile LAS unsigned* st) {
  XcdBarrier b; b.bar = bar; b.x = xb_xcc_id(); b.st = st;
  if (threadIdx.x == 0) (void)xb_add(&bar[XB_XCNT(b.x)], 1u);
  return b;
}
__device__ __forceinline__ void xcd_barrier_complete(unsigned* bar, unsigned x, unsigned& nloc, unsigned& nx) {
  const unsigned G = gridDim.x * gridDim.y * gridDim.z;
  unsigned sum, cnt, mine, sp = 0u;
  for (;;) {
    sum = 0u; cnt = 0u; mine = 0u;
#pragma unroll
    for (unsigned j = 0; j < 16; ++j) { const unsigned c = xb_ld(&bar[XB_XCNT(j)]); sum += c; cnt += (c > 0u) ? 1u : 0u; mine = (j == x) ? c : mine; }
    if (sum == G) break;
    __builtin_amdgcn_s_sleep(1);
    if ((++sp & 255u) == 0u) { if (xb_ld(&bar[XB_TMO])) break; if (sp > XB_SPIN_CAP) { atomicAdd(&bar[XB_TMO], 1u); break; } }
  }
  nloc = mine > 0u ? mine : 1u; nx = cnt > 0u ? cnt : 1u;
}
__device__ __forceinline__ void xcd_barrier(const XcdBarrier& b) {
  asm volatile("s_waitcnt vmcnt(0)" ::: "memory");
  __syncthreads();
  if (threadIdx.x == 0) {
    unsigned* bar = b.bar;
    __builtin_amdgcn_s_waitcnt(0);
    unsigned nloc = b.st[0], nx = b.st[1];
    if (nloc == 0u) { xcd_barrier_complete(bar, b.x, nloc, nx); b.st[0] = nloc; b.st[1] = nx; }
    const unsigned old = xb_add(&bar[XB_XSUB(b.x)], 1u);
    const unsigned gen = old / nloc;
    if (old + 1u == (gen + 1u) * nloc) {
      __builtin_amdgcn_fence(__ATOMIC_RELEASE, "agent");
      asm volatile("s_waitcnt vmcnt(0)" ::: "memory");
      const unsigned og = xb_add(&bar[XB_TOP], 1u);
      const unsigned tg = og / nx;
      if (og + 1u == (tg + 1u) * nx) xb_add(&bar[XB_TOPGEN], 1u);
      else XB_SPIN(xb_ld(&bar[XB_TOPGEN]) == tg, bar);
      __builtin_amdgcn_fence(__ATOMIC_ACQUIRE, "agent");
      xb_add(&bar[XB_XGEN(b.x)], 1u);
      asm volatile("s_waitcnt vmcnt(0)" ::: "memory");
    } else {
      XB_SPIN(xb_ld(&bar[XB_XGEN(b.x)]) == gen, bar);
      __builtin_amdgcn_fence(__ATOMIC_ACQUIRE, "agent");
      asm volatile("s_waitcnt vmcnt(0)" ::: "memory");
    }
  }
  __syncthreads();
}

constexpr int NPH = 17;
constexpr int SMEM_BYTES = 131072;

__global__ void __launch_bounds__(512, 2) mega(Params p, int ph_lo, int ph_hi, int coop) {
  __shared__ __attribute__((aligned(1024))) char smem[SMEM_BYTES + 16];
  if (threadIdx.x == 0) { *(volatile LAS unsigned*)(smem + SMEM_BYTES) = 0u; *(volatile LAS unsigned*)(smem + SMEM_BYTES + 4) = 0u; }
  __syncthreads();
  const XcdBarrier xb = xcd_barrier_post((unsigned*)(wsp(p) + OFF_BAR), (volatile LAS unsigned*)(smem + SMEM_BYTES));
  const u16* W = (const u16*)(wsp(p) + OFF_W);
  float* mod = (float*)(wsp(p) + OFF_MOD);
  const float* ropec = (const float*)(wsp(p) + OFF_ROPE);
  const float* ropes = ropec + 192 * 16;
  float* ssp = (float*)(wsp(p) + OFF_SSP);
  float* krope = (float*)(wsp(p) + OFF_KROPE);
  float* ctxr = (float*)(wsp(p) + OFF_CTXR);
#ifndef ONLY_PH
#define PH_SEL(n) true
#else
#define PH_SEL(n) ((n) == ONLY_PH)
#endif
#define PH_BEGIN(n) if (PH_SEL(n) && ph_lo <= (n) && (n) < ph_hi) {
#define PH_END(n) } if (coop && ph_lo <= (n) && (n) + 1 < ph_hi) { if (coop == 2) cg::this_grid().sync(); else xcd_barrier(xb); }
  {
    {
      PH_BEGIN(0) phase_prep(p, smem); PH_END(0)
      PH_BEGIN(1) phase_norm(p, 0); PH_END(1)
      PH_BEGIN(2) {
        EpDown ep{(u16*)(wsp(p) + OFF_F), krope, ssp};
        for (int t = blockIdx.x; t < 132 * 3; t += gridDim.x) {
          int mt, nt; tile_map(t, 132 * 3, 3, mt, nt);
          gemm_tile_w8<4>(smem, (const u16*)(wsp(p) + OFF_A), 1024, W + W_DQ, 1024, 704, 1024, mt * 256, nt * 256, ep);
        }
      } PH_END(2)
      PH_BEGIN(3) {
        u16* Ql = (u16*)(wsp(p) + OFF_C);
        EpQ epq{Ql, Ql + (size_t)32 * 8192 * 192, ssp, inp(p, 16), ropec, ropes};
        EpKV epk{(u16*)(wsp(p) + OFF_C + 99 * MiB), (u16*)(wsp(p) + OFF_B), ssp, krope, inp(p, 17), ropec, ropes};
        ALPlain alq{(const u16*)(wsp(p) + OFF_F), 640};
        for (int t = blockIdx.x; t < 132 * 16; t += gridDim.x) {
          int mt, r; tile_map(t, 132 * 16, 16, mt, r);
          if (r < 8) gemm_tile<6, 64>(smem, alq, W + W_UQ, 384, 1536, 384, mt * 256, r * 192, epq);
          else gemm_tile_w8<4>(smem, (const u16*)(wsp(p) + OFF_F) + 384, 640, W + W_UKV, 256, 2048, 256, mt * 256, (r - 8) * 256, epk);
        }
      } PH_END(3)
      PH_BEGIN(4) {
        for (int t = blockIdx.x; t < 1056; t += gridDim.x) attn_task(p, smem, t < 1024 ? ((t & 7) * 128 + (t >> 3)) : t);
      } PH_END(4)
      PH_BEGIN(5) {
        EpRes ep{inp(p, 0), inp(p, 2), outp(p), ctxr, mod + 2 * 1024};
        for (int t = blockIdx.x; t < 132 * 8; t += gridDim.x) {
          int mt, nt; tile_map(t, 132 * 8, 8, mt, nt);
          gemm_tile_w8<2>(smem, (const u16*)(wsp(p) + OFF_A), 1024, W + W_O0, 1024, 1024, 1024, mt * 256, nt * 128, ep);
        }
      } PH_END(5)
      PH_BEGIN(6) phase_norm(p, 1); PH_END(6)
      PH_BEGIN(7) {
        EpFfn1 ep{(u16*)(wsp(p) + OFF_C)};
        for (int t = blockIdx.x; t < 132 * 22; t += gridDim.x) {
          int mt, nt; tile_map(t, 132 * 22, 22, mt, nt);
          gemm_tile_w8<4>(smem, (const u16*)(wsp(p) + OFF_F), 1024, W + W_13, 1024, 5632, 1024, mt * 256, nt * 256, ep);
        }
      } PH_END(7)
      PH_BEGIN(8) {
        EpRes ep{outp(p), ctxr, outp(p), ctxr, mod + 5 * 1024};
        for (int t = blockIdx.x; t < 132 * 8; t += gridDim.x) {
          int mt, nt; tile_map(t, 132 * 8, 8, mt, nt);
          gemm_tile_w8<2>(smem, (const u16*)(wsp(p) + OFF_C), DFF, W + W_2, DFF, 1024, DFF, mt * 256, nt * 128, ep);
        }
      } PH_END(8)
      PH_BEGIN(9) phase_norm_shift(p); PH_END(9)
      PH_BEGIN(10) {
        u16* rbuf = (u16*)(wsp(p) + OFF_C);
        u16* hidw = (u16*)(wsp(p) + OFF_E);
        EpRw1 ep{rbuf, rbuf + (size_t)T_ALL * 1024, rbuf + (size_t)2 * T_ALL * 1024, hidw, hidw + (size_t)T_ALL * 128, hidw + (size_t)2 * T_ALL * 128};
        for (int t = blockIdx.x; t < 132 * 14; t += gridDim.x) {
          int mt, nt; tile_map(t, 132 * 14, 14, mt, nt);
          const int c0 = nt * 256;
          const int mi = c0 < 1024 ? 0 : c0 < 2048 ? 2 : c0 < 3072 ? 3 : c0 < 3328 ? -1 : 5;
          if (mi >= 0) {
            gemm_tile_w8m(smem, (const u16*)(wsp(p) + OFF_A), (const u16*)(wsp(p) + OFF_B), inp(p, 19) + mi * 1024, W + W_P1, 1024, 1024, mt * 256, c0, ep);
          } else {
            ALMix al1{(const u16*)(wsp(p) + OFF_A), (const u16*)(wsp(p) + OFF_B), inp(p, 19) + 1 * 1024};
            gemm_tile<4, 64>(smem, al1, W + W_P1, 1024, 3584, 1024, mt * 256, 3072, ep);
            ALMix al4{(const u16*)(wsp(p) + OFF_A), (const u16*)(wsp(p) + OFF_B), inp(p, 19) + 4 * 1024};
            gemm_tile<4, 64>(smem, al4, W + W_P1, 1024, 3584, 1024, mt * 256, 3200, ep);
          }
        }
      } PH_END(10)
      PH_BEGIN(11) {
        EpPlain ep{(u16*)(wsp(p) + OFF_F), 1024};
        for (int t = blockIdx.x; t < 256 + 128 * 4; t += gridDim.x) {
          if (t < 256) scan_task<16>(p, smem, t);
          else { const int u = t - 256; gemm_tile_w8<4>(smem, (const u16*)(wsp(p) + OFF_E) + (size_t)2 * T_ALL * 128, 256, W + W_G2, 192, 1024, 192, (u >> 2) * 256, (u & 3) * 256, ep); }
        }
      } PH_END(11)
      PH_BEGIN(12) phase_rwkv_out(p); PH_END(12)
      PH_BEGIN(13) {
        EpRes ep{outp(p), ctxr, outp(p), ctxr, mod + 5 * 6144 + 2 * 1024};
        for (int t = blockIdx.x; t < 128 * 4; t += gridDim.x) {
          int mt, nt; tile_map(t, 128 * 4, 4, mt, nt);
          gemm_tile_w8<4>(smem, (const u16*)(wsp(p) + OFF_C), 1024, W + W_O1, 1024, 1024, 1024, mt * 256, nt * 256, ep);
        }
      } PH_END(13)
      PH_BEGIN(14) phase_norm(p, 3); PH_END(14)
      PH_BEGIN(15) {
        EpFfn1 ep{(u16*)(wsp(p) + OFF_C)};
        for (int t = blockIdx.x; t < 128 * 22; t += gridDim.x) {
          int mt, nt; tile_map(t, 128 * 22, 22, mt, nt);
          gemm_tile_w8<4>(smem, (const u16*)(wsp(p) + OFF_A), 1024, W + W_13 + W13_SZ, 1024, 5632, 1024, mt * 256, nt * 256, ep);
        }
      } PH_END(15)
      PH_BEGIN(16) {
        EpRes ep{outp(p), ctxr, outp(p), ctxr, mod + 5 * 6144 + 5 * 1024};
        for (int t = blockIdx.x; t < 128 * 4; t += gridDim.x) {
          int mt, nt; tile_map(t, 128 * 4, 4, mt, nt);
          gemm_tile_w8<4>(smem, (const u16*)(wsp(p) + OFF_C), DFF, W + W_2 + W2_SZ, DFF, 1024, DFF, mt * 256, nt * 256, ep);
        }
      } PH_END(16)
    }
  }
}

extern "C" void kernel_launch(void* const* d_in, const int* in_sizes, int n_in, void* d_out, int out_size, void* d_ws,
                              size_t ws_size, hipStream_t stream) {
  static int grid_blocks = 0;
  if (!grid_blocks) {
    int dev = 0, cus = 0, per_cu = 0;
    (void)hipGetDevice(&dev);
    (void)hipDeviceGetAttribute(&cus, hipDeviceAttributeMultiprocessorCount, dev);
    (void)hipOccupancyMaxActiveBlocksPerMultiprocessor(&per_cu, mega, 512, 0);
    per_cu = 1;
    grid_blocks = cus * per_cu;
  }
  Params p{};
  for (int i = 0; i < 37; ++i) p.in[i] = (const float*)d_in[i];
  p.out = (float*)d_out;
  p.ws = (char*)d_ws;
  (void)hipMemsetAsync((char*)d_ws + OFF_BAR, 0, XCD_BAR_WORDS * sizeof(unsigned), stream);
  int lo = 0, hi = NPH, coop = 1;
  void* args[] = {&p, &lo, &hi, &coop};
  hipError_t e = hipLaunchCooperativeKernel((void*)mega, dim3(grid_blocks), dim3(512), args, 0, stream);
  if (e != hipSuccess) fprintf(stderr, "cooperative launch failed: %s (grid %d)\n", hipGetErrorString(e), grid_blocks);
}
```

```cpp
#include <hip/hip_runtime.h>
#include <hip/hip_cooperative_groups.h>
#include <stdint.h>
#include <stdio.h>
namespace cg = cooperative_groups;

#define LAS __attribute__((address_space(3)))
typedef unsigned short u16;
typedef __bf16 bf16x8 __attribute__((ext_vector_type(8)));
typedef __bf16 bf16x2 __attribute__((ext_vector_type(2)));
typedef float f32x2 __attribute__((ext_vector_type(2)));
typedef float f32x16 __attribute__((ext_vector_type(16)));
typedef float f32x4 __attribute__((ext_vector_type(4)));
typedef unsigned u32x4 __attribute__((ext_vector_type(4)));

constexpr int T_ALL = 33792, T_LAT = 32768;
constexpr int DFF = 2816;
constexpr size_t MiB = 1048576;
constexpr size_t OFF_MOD = 0;
constexpr size_t OFF_ROPE = 256 * 1024;
constexpr size_t OFF_SSP = 512 * 1024;
constexpr size_t OFF_KROPE = 2 * MiB;
constexpr size_t OFF_CTXR = 11 * MiB;
constexpr size_t OFF_BONUS = 15 * MiB;
constexpr size_t OFF_BAR = 19 * MiB;
constexpr size_t OFF_W = 20 * MiB;
constexpr size_t OFF_A = 69 * MiB;
constexpr size_t OFF_B = 135 * MiB;
constexpr size_t OFF_C = 201 * MiB;
constexpr size_t OFF_E = 399 * MiB;
constexpr size_t OFF_F = 432 * MiB;
constexpr size_t W_DQ = 0, W_UQ = 720896, W_UKV = 1310720, W_O0 = 1835008, W_13 = 2883584, W_2 = 14417920,
                 W_P1 = 20185088, W_O1 = 23855104, W_DW2 = 24903680, W_IA2 = 25034752, W_G2 = 25165824;
constexpr size_t W13_SZ = 5767168, W2_SZ = 2883584;

struct Params {
  const float* in[37];
  float* out;
  char* ws;
};

__device__ __forceinline__ const float* inp(const Params& p, int i) {
  int z;
  asm volatile("s_mov_b32 %0, 0" : "=s"(z));
  return p.in[i + z];
}
__device__ __forceinline__ char* wsp(const Params& p) {
  int z;
  asm volatile("s_mov_b32 %0, 0" : "=s"(z));
  return (&p.ws)[z];
}
__device__ __forceinline__ float* outp(const Params& p) {
  int z;
  asm volatile("s_mov_b32 %0, 0" : "=s"(z));
  return (&p.out)[z];
}
__device__ __forceinline__ float bf2f(u16 v) { return __uint_as_float(((unsigned)v) << 16); }
__device__ __forceinline__ unsigned pack2(float a, float b) {
  f32x2 f = {a, b};
  bf16x2 h = __builtin_convertvector(f, bf16x2);
  return __builtin_bit_cast(unsigned, h);
}
__device__ __forceinline__ u16 f2bf(float a) { return (u16)(pack2(a, 0.f) & 0xffffu); }
__device__ __forceinline__ float lo2f(unsigned u) { return __uint_as_float(u << 16); }
__device__ __forceinline__ float hi2f(unsigned u) { return __uint_as_float(u & 0xffff0000u); }

template <int CTRL>
__device__ __forceinline__ float dpp_f(float v) {
  return __int_as_float(__builtin_amdgcn_update_dpp(0, __float_as_int(v), CTRL, 0xF, 0xF, true));
}
__device__ __forceinline__ float red4(float v) { v += dpp_f<0xB1>(v); v += dpp_f<0x4E>(v); return v; }
__device__ __forceinline__ float red8(float v) { v = red4(v); v += dpp_f<0x141>(v); return v; }
__device__ __forceinline__ float red16(float v) { v = red8(v); v += dpp_f<0x140>(v); return v; }
__device__ __forceinline__ float swz16(float v) { return __int_as_float(__builtin_amdgcn_ds_swizzle(__float_as_int(v), 0x401F)); }
__device__ __forceinline__ float red32(float v) { v = red16(v); v += swz16(v); return v; }
__device__ __forceinline__ float max_x32(float v) {
  auto r = __builtin_amdgcn_permlane32_swap(__float_as_uint(v), __float_as_uint(v), false, false);
  return fmaxf(__uint_as_float(r[0]), __uint_as_float(r[1]));
}
__device__ __forceinline__ float red64(float v) { v = red32(v); v += __shfl_xor(v, 32); return v; }

__device__ __forceinline__ void lds_barrier() { asm volatile("s_waitcnt lgkmcnt(0)\n\ts_barrier" ::: "memory"); }
__device__ __forceinline__ float silu_f(float x) { return x * __builtin_amdgcn_rcpf(1.f + __expf(-x)); }
__device__ __forceinline__ float sigmoid_f(float x) { return __builtin_amdgcn_rcpf(1.f + __expf(-x)); }
__device__ __forceinline__ float tanh_f(float x) { float e = __expf(2.f * x); return 1.f - 2.f / (e + 1.f); }
__device__ __forceinline__ int roff(int i, int g) { return (i & 3) + 8 * (i >> 2) + 4 * g; }
__device__ __forceinline__ void pair_store_b(__amdgpu_buffer_rsrc_t rs, int voff, int soff, float va, float vb, int odd) {
  const float na = dpp_f<0xB1>(va), nb = dpp_f<0xB1>(vb);
  const unsigned w = odd ? pack2(nb, vb) : pack2(va, na);
  __builtin_amdgcn_raw_buffer_store_b32(w, rs, voff, soff, 0);
}
__device__ __forceinline__ void pair_store(u16* base, size_t ld, int rA, int col, float va, float vb, int lane) {
  const float na = dpp_f<0xB1>(va), nb = dpp_f<0xB1>(vb);
  const bool odd = lane & 1;
  const unsigned w = odd ? pack2(nb, vb) : pack2(va, na);
  *(unsigned*)(base + (size_t)(rA + (odd ? 1 : 0)) * ld + (col & ~1)) = w;
}

__device__ __forceinline__ f32x16 mfma32(bf16x8 a, bf16x8 b, f32x16 c) { return __builtin_amdgcn_mfma_f32_32x32x16_bf16(a, b, c, 0, 0, 0); }
__device__ __forceinline__ f32x4 mfma16(bf16x8 a, bf16x8 b, f32x4 c) { return __builtin_amdgcn_mfma_f32_16x16x32_bf16(a, b, c, 0, 0, 0); }

struct ALPlain {
  const u16* A; int lda;
  __device__ __forceinline__ uint4 load(int m, int k) const { return *(const uint4*)(A + (size_t)m * lda + k); }
};
struct ALMix {
  const u16* h; const u16* xx; const float* mix;
  __device__ __forceinline__ uint4 load(int m, int k) const {
    uint4 hv = *(const uint4*)(h + (size_t)m * 1024 + k);
    uint4 xv = *(const uint4*)(xx + (size_t)m * 1024 + k);
    float4 m0 = *(const float4*)(mix + k), m1 = *(const float4*)(mix + k + 4);
    uint4 r;
    r.x = pack2(lo2f(hv.x) + lo2f(xv.x) * m0.x, hi2f(hv.x) + hi2f(xv.x) * m0.y);
    r.y = pack2(lo2f(hv.y) + lo2f(xv.y) * m0.z, hi2f(hv.y) + hi2f(xv.y) * m0.w);
    r.z = pack2(lo2f(hv.z) + lo2f(xv.z) * m1.x, hi2f(hv.z) + hi2f(xv.z) * m1.y);
    r.w = pack2(lo2f(hv.w) + lo2f(xv.w) * m1.z, hi2f(hv.w) + hi2f(xv.w) * m1.w);
    return r;
  }
};

template <int TN, int BK, class AL, class EP>
__device__ __forceinline__ void gemm_tile(char* smem, const AL& al, const u16* __restrict__ Bw, int ldb, int nvalid,
                                          int K, int m0, int n0, const EP& ep) {
  constexpr int LS = BK + 8;
  constexpr int CPR = BK / 8;
  constexpr int RPI = 512 / CPR;
  constexpr int NA = 256 / RPI, NB = TN * 32 / RPI;
  u16* As = (u16*)smem;
  u16* Bs = As + 256 * LS;
  const int tid = threadIdx.x, lane = tid & 63, wid = tid >> 6, lr = lane & 31, g = lane >> 5;
  f32x16 acc[TN];
#pragma unroll
  for (int nt = 0; nt < TN; ++nt)
#pragma unroll
    for (int i = 0; i < 16; ++i) acc[nt][i] = 0.f;
  uint4 ra[NA], rb[NB];
  const int crow = tid / CPR, ckc = (tid % CPR) * 8;
  auto gload = [&](int k0) {
#pragma unroll
    for (int i = 0; i < NA; ++i) ra[i] = al.load(m0 + crow + RPI * i, k0 + ckc);
#pragma unroll
    for (int i = 0; i < NB; ++i) {
      int n = n0 + crow + RPI * i;
      rb[i] = (n < nvalid) ? *(const uint4*)(Bw + (size_t)n * ldb + k0 + ckc) : make_uint4(0, 0, 0, 0);
    }
  };
  gload(0);
  const int nk = K / BK;
  for (int kt = 0; kt < nk; ++kt) {
    __syncthreads();
#pragma unroll
    for (int i = 0; i < NA; ++i) *(uint4*)(As + (crow + RPI * i) * LS + ckc) = ra[i];
#pragma unroll
    for (int i = 0; i < NB; ++i) *(uint4*)(Bs + (crow + RPI * i) * LS + ckc) = rb[i];
    __syncthreads();
    if (kt + 1 < nk) gload((kt + 1) * BK);
#pragma unroll(TN > 4 ? 1 : 4)
    for (int ks = 0; ks < BK / 16; ++ks) {
      bf16x8 a = *(const bf16x8*)(As + (wid * 32 + lr) * LS + ks * 16 + g * 8);
#pragma unroll
      for (int nt = 0; nt < TN; ++nt) {
        bf16x8 b = *(const bf16x8*)(Bs + (nt * 32 + lr) * LS + ks * 16 + g * 8);
        acc[nt] = mfma32(a, b, acc[nt]);
      }
    }
  }
  int lane2 = lane;
  asm volatile("" : "+v"(lane2));
  ep(acc, m0 + wid * 32, n0, lane2);
}

#define WAIT_V(n) asm volatile("s_waitcnt vmcnt(%0)" ::"n"(n) : "memory")
template <int TNW, class EP>
__device__ __forceinline__ void gemm_tile_w8(char* smem, const u16* __restrict__ A, int lda, const u16* __restrict__ Bw,
                                             int ldb, int nvalid, int K, int m0, int n0, const EP& ep) {
  constexpr int ABYTES = 256 * 128, BBYTES = TNW * 64 * 128, STAGE = ABYTES + BBYTES;
  const int tid = threadIdx.x, lane = tid & 63, lr = lane & 31, g = lane >> 5;
  const int wid = __builtin_amdgcn_readfirstlane(tid >> 6);
  const int wm = wid >> 1, wn = wid & 1;
  const int rl = lane >> 3, cp = lane & 7;
  unsigned ag[4], bg[TNW];
  const __amdgpu_buffer_rsrc_t rsA = __builtin_amdgcn_make_buffer_rsrc((void*)A, 0, 0x7fffffff, 0x00020000);
  const __amdgpu_buffer_rsrc_t rsB = __builtin_amdgcn_make_buffer_rsrc((void*)Bw, 0, 0x7fffffff, 0x00020000);
#pragma unroll
  for (int i = 0; i < 4; ++i) {
    const int row = (i * 8 + wid) * 8 + rl;
    const int c = cp ^ ((row >> 1) & 7);
    ag[i] = (unsigned)((m0 + row) * lda + c * 8) * 2u;
  }
#pragma unroll
  for (int i = 0; i < TNW; ++i) {
    const int row = (i * 8 + wid) * 8 + rl;
    const int c = cp ^ ((row >> 1) & 7);
    int n = n0 + row;
    n = n < nvalid ? n : nvalid - 1;
    bg[i] = (unsigned)(n * ldb + c * 8) * 2u;
  }
#define GLDS_STAGE(BUF, K0)                                                                                          \
  {                                                                                                                  \
    _Pragma("unroll") for (int i = 0; i < 4; ++i) __builtin_amdgcn_raw_ptr_buffer_load_lds(                          \
        rsA, (LAS void*)(smem + (BUF) * STAGE + (i * 8 + wid) * 1024), 16, ag[i], (K0) * 2, 0, 0);                   \
    _Pragma("unroll") for (int i = 0; i < TNW; ++i) __builtin_amdgcn_raw_ptr_buffer_load_lds(                        \
        rsB, (LAS void*)(smem + (BUF) * STAGE + ABYTES + (i * 8 + wid) * 1024), 16, bg[i], (K0) * 2, 0, 0);          \
  }
  f32x16 acc[2][TNW];
#pragma unroll
  for (int tm = 0; tm < 2; ++tm)
#pragma unroll
    for (int nt = 0; nt < TNW; ++nt)
#pragma unroll
      for (int i = 0; i < 16; ++i) acc[tm][nt][i] = 0.f;
  const int sw = (lr >> 1) & 7;
  const int aoff = (wm * 64 + lr) * 128, boff = ABYTES + (wn * TNW * 32 + lr) * 128;
  const int nk = K >> 6;
  WAIT_V(0);
  __syncthreads();
  GLDS_STAGE(0, 0)
  int cur = 0;
#pragma unroll 2
  for (int kt = 0; kt < nk; ++kt) {
    WAIT_V(0);
    lds_barrier();
    if (kt + 1 < nk) GLDS_STAGE(cur ^ 1, (kt + 1) * 64)
    const char* sb = smem + cur * STAGE;
#pragma unroll 2
    for (int ks = 0; ks < 4; ++ks) {
      const int pos = ((ks * 2 + g) ^ sw) * 16;
      bf16x8 a0 = *(const bf16x8*)(sb + aoff + pos);
      bf16x8 a1 = *(const bf16x8*)(sb + aoff + 4096 + pos);
#pragma unroll
      for (int nt = 0; nt < TNW; ++nt) {
        bf16x8 b = *(const bf16x8*)(sb + boff + nt * 4096 + pos);
        acc[0][nt] = mfma32(a0, b, acc[0][nt]);
        acc[1][nt] = mfma32(a1, b, acc[1][nt]);
      }
    }
    cur ^= 1;
  }
#undef GLDS_STAGE
  int lane2 = lane;
  asm volatile("" : "+v"(lane2));
  ep(acc[0], m0 + wm * 64, n0 + wn * TNW * 32, lane2);
  asm volatile("" : "+v"(lane2));
  ep(acc[1], m0 + wm * 64 + 32, n0 + wn * TNW * 32, lane2);
}

template <class EP>
__device__ __forceinline__ void gemm_tile_w8m(char* smem, const u16* __restrict__ H, const u16* __restrict__ X,
                                              const float* __restrict__ mix, const u16* __restrict__ Bw, int ldb,
                                              int K, int m0, int n0, const EP& ep) {
  constexpr int TNW = 4;
  constexpr int ABYTES = 256 * 128, BBYTES = TNW * 64 * 128, STAGE = ABYTES + BBYTES;
  const int tid = threadIdx.x, lane = tid & 63, lr = lane & 31, g = lane >> 5;
  const int wid = __builtin_amdgcn_readfirstlane(tid >> 6);
  const int wm = wid >> 1, wn = wid & 1;
  const int rl = lane >> 3, cp = lane & 7;
  unsigned bg[TNW];
#pragma unroll
  for (int i = 0; i < TNW; ++i) {
    const int row = (i * 8 + wid) * 8 + rl;
    const int c = cp ^ ((row >> 1) & 7);
    bg[i] = (unsigned)((n0 + row) * ldb + c * 8) * 2u;
  }
  const int ac = tid & 7, ar0 = tid >> 3;
  const unsigned aoffg = (unsigned)((m0 + ar0) * 1024 + ac * 8);
  u32x4 rh[4], rx[4];
  const __amdgpu_buffer_rsrc_t rsH = __builtin_amdgcn_make_buffer_rsrc((void*)H, 0, 0x7fffffff, 0x00020000);
  const __amdgpu_buffer_rsrc_t rsX = __builtin_amdgcn_make_buffer_rsrc((void*)X, 0, 0x7fffffff, 0x00020000);
  const int aoffb = (int)(aoffg * 2u);
#define LOAD_A(K0)                                                                                   \
  {                                                                                                  \
    _Pragma("unroll") for (int i = 0; i < 4; ++i) {                                                  \
      rh[i] = __builtin_amdgcn_raw_buffer_load_b128(rsH, aoffb, (i * 65536 + (K0)) * 2, 0);          \
      rx[i] = __builtin_amdgcn_raw_buffer_load_b128(rsX, aoffb, (i * 65536 + (K0)) * 2, 0);          \
    }                                                                                                \
  }
  const __amdgpu_buffer_rsrc_t rsB = __builtin_amdgcn_make_buffer_rsrc((void*)Bw, 0, 0x7fffffff, 0x00020000);
#define GLDS_B(BUF, K0)                                                                              \
  {                                                                                                  \
    _Pragma("unroll") for (int i = 0; i < TNW; ++i) __builtin_amdgcn_raw_ptr_buffer_load_lds(        \
        rsB, (LAS void*)(smem + (BUF) * STAGE + ABYTES + (i * 8 + wid) * 1024), 16, bg[i], (K0) * 2, 0, 0); \
  }
  f32x16 acc[2][TNW];
#pragma unroll
  for (int tm = 0; tm < 2; ++tm)
#pragma unroll
    for (int nt = 0; nt < TNW; ++nt)
#pragma unroll
      for (int i = 0; i < 16; ++i) acc[tm][nt][i] = 0.f;
  const int sw = (lr >> 1) & 7;
  const int aoff = (wm * 64 + lr) * 128, boff = ABYTES + (wn * TNW * 32 + lr) * 128;
  const int nk = K >> 6;
  WAIT_V(0);
  __syncthreads();
  GLDS_B(0, 0)
  LOAD_A(0)
  int cur = 0;
  for (int kt = 0; kt < nk; ++kt) {
    const float4 m0v = *(const float4*)(mix + kt * 64 + ac * 8), m1v = *(const float4*)(mix + kt * 64 + ac * 8 + 4);
    WAIT_V(0);
    {
      char* ab = smem + cur * STAGE;
#pragma unroll
      for (int i = 0; i < 4; ++i) {
        const int row = ar0 + 64 * i;
        u32x4 o;
        o[0] = pack2(lo2f(rh[i][0]) + lo2f(rx[i][0]) * m0v.x, hi2f(rh[i][0]) + hi2f(rx[i][0]) * m0v.y);
        o[1] = pack2(lo2f(rh[i][1]) + lo2f(rx[i][1]) * m0v.z, hi2f(rh[i][1]) + hi2f(rx[i][1]) * m0v.w);
        o[2] = pack2(lo2f(rh[i][2]) + lo2f(rx[i][2]) * m1v.x, hi2f(rh[i][2]) + hi2f(rx[i][2]) * m1v.y);
        o[3] = pack2(lo2f(rh[i][3]) + lo2f(rx[i][3]) * m1v.z, hi2f(rh[i][3]) + hi2f(rx[i][3]) * m1v.w);
        *(u32x4*)(ab + row * 128 + ((ac ^ ((row >> 1) & 7)) << 4)) = o;
      }
    }
    lds_barrier();
    if (kt + 1 < nk) { GLDS_B(cur ^ 1, (kt + 1) * 64) LOAD_A((kt + 1) * 64) }
    const char* sb = smem + cur * STAGE;
#pragma unroll 2
    for (int ks = 0; ks < 4; ++ks) {
      const int pos = ((ks * 2 + g) ^ sw) * 16;
      bf16x8 a0 = *(const bf16x8*)(sb + aoff + pos);
      bf16x8 a1 = *(const bf16x8*)(sb + aoff + 4096 + pos);
#pragma unroll
      for (int nt = 0; nt < TNW; ++nt) {
        bf16x8 bb = *(const bf16x8*)(sb + boff + nt * 4096 + pos);
        acc[0][nt] = mfma32(a0, bb, acc[0][nt]);
        acc[1][nt] = mfma32(a1, bb, acc[1][nt]);
      }
    }
    cur ^= 1;
  }
#undef LOAD_A
#undef GLDS_B
  int lane2 = lane;
  asm volatile("" : "+v"(lane2));
  ep(acc[0], m0 + wm * 64, n0 + wn * TNW * 32, lane2);
  asm volatile("" : "+v"(lane2));
  ep(acc[1], m0 + wm * 64 + 32, n0 + wn * TNW * 32, lane2);
}

struct EpDown {
  u16* down; float* krope; float* ssp;
  __device__ __forceinline__ void operator()(f32x16 (&acc)[4], int mw, int n0, int lane) const {
    const int lr = lane & 31, g = lane >> 5;
    float ssq[16];
#pragma unroll
    for (int i = 0; i < 16; ++i) ssq[i] = 0.f;
#pragma unroll
    for (int nt = 0; nt < 4; ++nt) {
      const int col = n0 + nt * 32 + lr;
#pragma unroll
      for (int i = 0; i < 16; ++i) {
        const int row = mw + roff(i, g);
        const float v = acc[nt][i];
        if (col < 640) { down[(size_t)row * 640 + col] = f2bf(v); ssq[i] += v * v; }
        else if (col < 704) { krope[(size_t)row * 64 + col - 640] = v; ssq[i] += v * v; }
      }
    }
#pragma unroll
    for (int i = 0; i < 16; ++i) {
      float s = red32(ssq[i]);
      if (lr == 0) ssp[(size_t)(mw + roff(i, g)) * 8 + (n0 >> 7)] = s;
    }
  }
};

constexpr float QSCALE = 0.07216878364870323f * 1.4426950408889634f;

struct EpQ {
  u16* Ql; u16* Qc; const float* ssp; const float* gq; const float* ropec; const float* ropes;
  __device__ __forceinline__ void operator()(f32x16 (&acc)[6], int mw, int n0, int lane) const {
    const int lr = lane & 31, g = lane >> 5;
    const int h = n0 / 192;
    int b, s0, isc;
    if (mw < T_LAT) { b = mw >> 13; s0 = mw & 8191; isc = 0; } else { int u = mw - T_LAT; b = u >> 8; s0 = u & 255; isc = 1; }
    float gv[6];
#pragma unroll
    for (int nt = 0; nt < 6; ++nt) gv[nt] = gq[nt * 32 + lr];
#pragma unroll
    for (int i = 0; i < 16; ++i) {
      const int row = mw + roff(i, g);
      const float* sp = ssp + (size_t)row * 8;
      const float rsq = rsqrtf((sp[0] + sp[1] + sp[2]) * (1.f / 384.f) + 1e-6f);
      float ss = 0.f;
#pragma unroll
      for (int nt = 0; nt < 6; ++nt) { float v = acc[nt][i] * rsq; acc[nt][i] = v; ss += v * v; }
      ss = red32(ss);
      const float rn = rsqrtf(ss * (1.f / 192.f) + 1e-6f);
#pragma unroll
      for (int nt = 0; nt < 6; ++nt) acc[nt][i] *= rn * gv[nt];
      if ((i & 3) == 3) asm volatile("" ::: "memory");
    }
    if (!isc) {
      const int f = lr & 15, hi = lr >> 4;
#pragma unroll
      for (int i = 0; i < 16; ++i) {
        const int s = s0 + roff(i, g);
        const int p0 = s >> 6, p1 = 128 + (s & 63);
        float cs = ropec[p0 * 16 + f], sn = ropes[p0 * 16 + f];
        float x = acc[4][i], px = swz16(x);
        acc[4][i] = hi ? (px * sn + x * cs) : (x * cs - px * sn);
        cs = ropec[p1 * 16 + f]; sn = ropes[p1 * 16 + f];
        x = acc[5][i]; px = swz16(x);
        acc[5][i] = hi ? (px * sn + x * cs) : (x * cs - px * sn);
        }
    }
    u16* base = isc ? (Qc + ((size_t)(b * 8 + h) * 256 + s0) * 192) : (Ql + ((size_t)(b * 8 + h) * 8192 + s0) * 192);
#pragma unroll
    for (int nt = 0; nt < 6; ++nt)
#pragma unroll
      for (int i = 0; i < 16; i += 2)
        pair_store(base, 192, roff(i, g), nt * 32 + lr, acc[nt][i] * QSCALE, acc[nt][i + 1] * QSCALE, lane);
  }
};

struct EpKV {
  u16* Kb; u16* Vt; const float* ssp; const float* krope; const float* gk; const float* ropec; const float* ropes;
  __device__ __forceinline__ void operator()(f32x16 (&acc)[4], int mw, int n0, int lane) const {
    const int lr = lane & 31, g = lane >> 5;
    const int h = n0 >> 8, isv = (n0 >> 7) & 1;
    int b, s0, isc;
    if (mw < T_LAT) { b = mw >> 13; s0 = mw & 8191; isc = 0; } else { int u = mw - T_LAT; b = u >> 8; s0 = u & 255; isc = 1; }
    const int key0 = isc ? s0 : 256 + s0;
    const int bh = b * 8 + h;
    float rs[16];
#pragma unroll
    for (int i = 0; i < 16; ++i) {
      const float* sp = ssp + (size_t)(mw + roff(i, g)) * 8;
      rs[i] = rsqrtf((sp[3] + sp[4]) * (1.f / 256.f) + 1e-6f);
    }
    if (isv) {
#pragma unroll
      for (int nt = 0; nt < 4; ++nt) {
        u16* vrow = Vt + ((size_t)bh * 128 + nt * 32 + lr) * 8448 + key0;
#pragma unroll
        for (int ap = 0; ap < 2; ++ap) {
          const int a0 = 8 * ap;
          uint4 w;
          w.x = pack2(acc[nt][a0 + 0] * rs[a0 + 0], acc[nt][a0 + 1] * rs[a0 + 1]);
          w.y = pack2(acc[nt][a0 + 2] * rs[a0 + 2], acc[nt][a0 + 3] * rs[a0 + 3]);
          w.z = pack2(acc[nt][a0 + 4] * rs[a0 + 4], acc[nt][a0 + 5] * rs[a0 + 5]);
          w.w = pack2(acc[nt][a0 + 6] * rs[a0 + 6], acc[nt][a0 + 7] * rs[a0 + 7]);
          *(uint4*)(vrow + 16 * ap + 8 * g) = w;
        }
      }
    } else {
      float gv[4];
#pragma unroll
      for (int nt = 0; nt < 4; ++nt) gv[nt] = gk[nt * 32 + lr];
      const float g0 = gk[128 + lr], g1 = gk[160 + lr];
      const int f = lr & 15, hi = lr >> 4;
      float t0[16], t1[16];
#pragma unroll
      for (int i = 0; i < 16; ++i) {
        const int r = roff(i, g);
        const int row = mw + r;
        float ss = 0.f;
#pragma unroll
        for (int nt = 0; nt < 4; ++nt) { float v = acc[nt][i] * rs[i]; acc[nt][i] = v; ss += v * v; }
        ss = red32(ss) + ssp[(size_t)row * 8 + 5];
        const float rk = rsqrtf(ss * (1.f / 192.f) + 1e-6f);
#pragma unroll
        for (int nt = 0; nt < 4; ++nt) acc[nt][i] *= rk * gv[nt];
        float x0 = krope[(size_t)row * 64 + lr] * rk * g0;
        float x1 = krope[(size_t)row * 64 + 32 + lr] * rk * g1;
        if (!isc) {
          const int s = s0 + r;
          const int p0 = s >> 6, p1 = 128 + (s & 63);
          float cs = ropec[p0 * 16 + f], sn = ropes[p0 * 16 + f];
          float px = swz16(x0);
          x0 = hi ? (px * sn + x0 * cs) : (x0 * cs - px * sn);
          cs = ropec[p1 * 16 + f]; sn = ropes[p1 * 16 + f];
          px = swz16(x1);
          x1 = hi ? (px * sn + x1 * cs) : (x1 * cs - px * sn);
        }
        t0[i] = x0; t1[i] = x1;
        if ((i & 3) == 3) asm volatile("" ::: "memory");
      }
      u16* kbase = Kb + ((size_t)bh * 8448 + key0) * 192;
#pragma unroll
      for (int i = 0; i < 16; i += 2) {
#pragma unroll
        for (int nt = 0; nt < 4; ++nt) pair_store(kbase, 192, roff(i, g), nt * 32 + lr, acc[nt][i], acc[nt][i + 1], lane);
        pair_store(kbase, 192, roff(i, g), 128 + lr, t0[i], t0[i + 1], lane);
        pair_store(kbase, 192, roff(i, g), 160 + lr, t1[i], t1[i + 1], lane);
      }
    }
  }
};

struct EpRes {
  const float* srcL; const float* srcC; float* dstL; float* dstC; const float* gate;
  template <int NT>
  __device__ __forceinline__ void operator()(f32x16 (&acc)[NT], int mw, int n0, int lane) const {
    const int lr = lane & 31, g = lane >> 5;
    const bool lat = mw < T_LAT;
    const int mwl = lat ? mw : mw - T_LAT;
    const int gb = lat ? (mw >> 13) : 4;
    const __amdgpu_buffer_rsrc_t rsS = __builtin_amdgcn_make_buffer_rsrc((void*)(lat ? srcL : srcC), 0, 0x7fffffff, 0x00020000);
    const __amdgpu_buffer_rsrc_t rsD = __builtin_amdgcn_make_buffer_rsrc((void*)(lat ? dstL : dstC), 0, 0x7fffffff, 0x00020000);
    const int voff = (4 * g * 1024 + lr) * 4;
#pragma unroll
    for (int nt = 0; nt < NT; ++nt) {
      const int col = n0 + nt * 32 + lr;
      const float gv = gate[gb * 6144 + col];
#pragma unroll
      for (int i = 0; i < 16; ++i) {
        const int soff = ((mwl + (i & 3) + 8 * (i >> 2)) * 1024 + n0 + nt * 32) * 4;
        const float sv = __uint_as_float(__builtin_amdgcn_raw_buffer_load_b32(rsS, voff, soff, 0));
        __builtin_amdgcn_raw_buffer_store_b32(__float_as_uint(sv + gv * acc[nt][i]), rsD, voff, soff, 0);
      }
    }
  }
};

struct EpFfn1 {
  u16* hid;
  __device__ __forceinline__ void operator()(f32x16 (&acc)[4], int mw, int n0, int lane) const {
    const int lr = lane & 31, g = lane >> 5, odd = lane & 1;
    const __amdgpu_buffer_rsrc_t rs = __builtin_amdgcn_make_buffer_rsrc((void*)hid, 0, 0x7fffffff, 0x00020000);
    const int voff = ((4 * g + odd) * DFF + (((n0 >> 7) * 64 + lr) & ~1)) * 2;
#pragma unroll
    for (int nt = 0; nt < 2; ++nt) {
#pragma unroll
      for (int i = 0; i < 16; i += 2) {
        const float va = silu_f(acc[nt][i]) * acc[nt + 2][i], vb = silu_f(acc[nt][i + 1]) * acc[nt + 2][i + 1];
        const float na = dpp_f<0xB1>(va), nb = dpp_f<0xB1>(vb);
        const unsigned w = odd ? pack2(nb, vb) : pack2(va, na);
        const int soff = ((mw + (i & 3) + 8 * (i >> 2)) * DFF + nt * 32) * 2;
        __builtin_amdgcn_raw_buffer_store_b32(w, rs, voff, soff, 0);
      }
    }
  }
};

struct EpRw1 {
  u16* r; u16* k; u16* v; u16* hidw; u16* hida; u16* hidg;
  __device__ __forceinline__ void operator()(f32x16 (&acc)[4], int mw, int n0, int lane) const {
    const int lr = lane & 31, g = lane >> 5;
    u16* dst; int ld, c0, act;
    if (n0 < 1024) { dst = r; ld = 1024; c0 = n0; act = 0; }
    else if (n0 < 2048) { dst = k; ld = 1024; c0 = n0 - 1024; act = 0; }
    else if (n0 < 3072) { dst = v; ld = 1024; c0 = n0 - 2048; act = 0; }
    else if (n0 < 3200) { dst = hidw; ld = 128; c0 = 0; act = 1; }
    else if (n0 < 3328) { dst = hida; ld = 128; c0 = 0; act = 0; }
    else { dst = hidg; ld = 256; c0 = n0 - 3328; act = 2; }
    const int odd = lane & 1;
    const __amdgpu_buffer_rsrc_t rs = __builtin_amdgcn_make_buffer_rsrc((void*)dst, 0, 0x7fffffff, 0x00020000);
    const int voff = ((4 * g + odd) * ld + (lr & ~1)) * 2;
#pragma unroll
    for (int nt = 0; nt < 4; ++nt) {
#pragma unroll
      for (int i = 0; i < 16; i += 2) {
        float x = acc[nt][i], y = acc[nt][i + 1];
        if (act == 1) { x = tanh_f(x); y = tanh_f(y); } else if (act == 2) { x = sigmoid_f(x); y = sigmoid_f(y); }
        pair_store_b(rs, voff, ((mw + (i & 3) + 8 * (i >> 2)) * ld + c0 + nt * 32) * 2, x, y, odd);
      }
    }
  }
};

struct EpPlain {
  u16* dst; int ld;
  __device__ __forceinline__ void operator()(f32x16 (&acc)[4], int mw, int n0, int lane) const {
    const int lr = lane & 31, g = lane >> 5;
#pragma unroll
    for (int nt = 0; nt < 4; ++nt)
#pragma unroll
      for (int i = 0; i < 16; i += 2)
        pair_store(dst, ld, mw + roff(i, g), n0 + nt * 32 + lr, acc[nt][i], acc[nt][i + 1], lane);
  }
};

struct Job {
  const float* src; int ld, K, N; u16* dst; int Kpad, Npad, ldd, blk, rowstep, rowoff; const float* scale;
};
__device__ __forceinline__ Job mkjob(const float* src, int ld, int K, int N, u16* dst, int Kpad, int Npad, int ldd,
                                     int blk, int rowstep, int rowoff, const float* scale) {
  Job j; j.src = src; j.ld = ld; j.K = K; j.N = N; j.dst = dst; j.Kpad = Kpad; j.Npad = Npad; j.ldd = ldd;
  j.blk = blk; j.rowstep = rowstep; j.rowoff = rowoff; j.scale = scale; return j;
}
constexpr int NJOBS = 24;
__device__ __forceinline__ Job get_job(const Params& p, int j) {
  u16* W = (u16*)(wsp(p) + OFF_W);
  switch (j) {
    case 0: return mkjob(inp(p, 11), 704, 1024, 704, W + W_DQ, 1024, 704, 1024, 704, 0, 0, nullptr);
    case 1: return mkjob(inp(p, 14), 1536, 384, 1536, W + W_UQ, 384, 1536, 384, 1536, 0, 0, inp(p, 12));
    case 2: return mkjob(inp(p, 15), 2048, 256, 2048, W + W_UKV, 256, 2048, 256, 2048, 0, 0, inp(p, 13));
    case 3: return mkjob(inp(p, 18), 1024, 1024, 1024, W + W_O0, 1024, 1024, 1024, 1024, 0, 0, nullptr);
    case 4: return mkjob(inp(p, 8), DFF, 1024, DFF, W + W_13, 1024, DFF, 1024, 64, 128, 0, nullptr);
    case 5: return mkjob(inp(p, 9), DFF, 1024, DFF, W + W_13, 1024, DFF, 1024, 64, 128, 64, nullptr);
    case 6: return mkjob(inp(p, 10), 1024, DFF, 1024, W + W_2, DFF, 1024, DFF, 1024, 0, 0, nullptr);
    case 7: return mkjob(inp(p, 8) + 1024 * DFF, DFF, 1024, DFF, W + W_13 + W13_SZ, 1024, DFF, 1024, 64, 128, 0, nullptr);
    case 8: return mkjob(inp(p, 9) + 1024 * DFF, DFF, 1024, DFF, W + W_13 + W13_SZ, 1024, DFF, 1024, 64, 128, 64, nullptr);
    case 9: return mkjob(inp(p, 10) + 1024 * DFF, 1024, DFF, 1024, W + W_2 + W2_SZ, DFF, 1024, DFF, 1024, 0, 0, nullptr);
    case 10: return mkjob(inp(p, 20), 1024, 1024, 1024, W + W_P1, 1024, 1024, 1024, 1024, 0, 0, nullptr);
    case 11: return mkjob(inp(p, 21), 1024, 1024, 1024, W + W_P1, 1024, 1024, 1024, 1024, 0, 1024, nullptr);
    case 12: return mkjob(inp(p, 22), 1024, 1024, 1024, W + W_P1, 1024, 1024, 1024, 1024, 0, 2048, nullptr);
    case 13: return mkjob(inp(p, 28), 64, 1024, 64, W + W_P1, 1024, 64, 1024, 64, 0, 3072, nullptr);
    case 14: return mkjob(inp(p, 28) + 65536, 64, 1024, 64, W + W_P1, 1024, 64, 1024, 64, 0, 3136, nullptr);
    case 15: return mkjob(inp(p, 31), 64, 1024, 64, W + W_P1, 1024, 64, 1024, 64, 0, 3200, nullptr);
    case 16: return mkjob(inp(p, 31) + 65536, 64, 1024, 64, W + W_P1, 1024, 64, 1024, 64, 0, 3264, nullptr);
    case 17: return mkjob(inp(p, 33), 160, 1024, 160, W + W_P1, 1024, 256, 1024, 256, 0, 3328, nullptr);
    case 18: return mkjob(inp(p, 23), 1024, 1024, 1024, W + W_O1, 1024, 1024, 1024, 1024, 0, 0, nullptr);
    case 19: return mkjob(inp(p, 29), 1024, 64, 1024, W + W_DW2, 64, 1024, 64, 1024, 0, 0, nullptr);
    case 20: return mkjob(inp(p, 29) + 65536, 1024, 64, 1024, W + W_DW2 + 65536, 64, 1024, 64, 1024, 0, 0, nullptr);
    case 21: return mkjob(inp(p, 32), 1024, 64, 1024, W + W_IA2, 64, 1024, 64, 1024, 0, 0, nullptr);
    case 22: return mkjob(inp(p, 32) + 65536, 1024, 64, 1024, W + W_IA2 + 65536, 64, 1024, 64, 1024, 0, 0, nullptr);
    default: return mkjob(inp(p, 34), 1024, 160, 1024, W + W_G2, 192, 1024, 192, 1024, 0, 0, nullptr);
  }
}

__device__ __forceinline__ void transpose_tile(const Job& jb, int tile, char* smem, bool valid) {
  const int half = threadIdx.x >> 8, tid = threadIdx.x & 255;
  float* ts = (float*)smem + half * (64 * 65);
  const int nkt = jb.Kpad >> 6;
  const int kt = tile % nkt, nt = tile / nkt;
  __syncthreads();
  if (valid) {
    const int col = tid & 63, rb = tid >> 6;
    const int n = nt * 64 + col;
#pragma unroll 4
    for (int i = 0; i < 16; ++i) {
      const int kk = rb + 4 * i, k = kt * 64 + kk;
      float v = 0.f;
      if (k < jb.K && n < jb.N) { v = jb.src[(size_t)k * jb.ld + n]; if (jb.scale) v *= jb.scale[k]; }
      ts[kk * 65 + col] = v;
    }
  }
  __syncthreads();
  if (valid) {
    const int nl = tid >> 2, kc = (tid & 3) * 16;
    const int n = nt * 64 + nl;
    const int drow = (n / jb.blk) * jb.rowstep + jb.rowoff + (n % jb.blk);
    unsigned w[8];
#pragma unroll
    for (int j = 0; j < 8; ++j) w[j] = pack2(ts[(kc + 2 * j) * 65 + nl], ts[(kc + 2 * j + 1) * 65 + nl]);
    uint4* d = (uint4*)(jb.dst + (size_t)drow * jb.ldd + kt * 64 + kc);
    d[0] = make_uint4(w[0], w[1], w[2], w[3]);
    d[1] = make_uint4(w[4], w[5], w[6], w[7]);
  }
}

__device__ __forceinline__ void mods_task(const Params& p, int task, char* smem) {
  float* sc = (float*)smem;
  float* part = sc + 5 * 1024;
  const int layer = task / 96, j0 = (task % 96) * 64;
  const int tid = threadIdx.x;
  __syncthreads();
  for (int i = tid; i < 5 * 1024; i += 512) {
    const int r = i >> 10, k = i & 1023;
    const float cv = (r < 4) ? inp(p, 1)[r * 1024 + k] : inp(p, 3)[k];
    sc[i] = silu_f(cv);
  }
  __syncthreads();
  const int col = tid & 63, kp = tid >> 6;
  const float* w = inp(p, 4) + (size_t)layer * 1024 * 6144 + j0 + col;
  float a[5] = {0.f, 0.f, 0.f, 0.f, 0.f};
#pragma unroll 8
  for (int k = kp * 128; k < kp * 128 + 128; ++k) {
    const float wv = w[(size_t)k * 6144];
#pragma unroll
    for (int r = 0; r < 5; ++r) a[r] += sc[r * 1024 + k] * wv;
  }
#pragma unroll
  for (int r = 0; r < 5; ++r) part[(kp * 5 + r) * 64 + col] = a[r];
  __syncthreads();
  for (int i = tid; i < 320; i += 512) {
    const int r = i >> 6, c = i & 63;
    float s = 0.f;
#pragma unroll
    for (int q = 0; q < 8; ++q) s += part[(q * 5 + r) * 64 + c];
    float* mod = (float*)(wsp(p) + OFF_MOD);
    mod[(layer * 5 + r) * 6144 + j0 + c] = s + inp(p, 5)[layer * 6144 + j0 + c];
  }
}

__device__ __forceinline__ void rope_task(const Params& p) {
  const float invf[16] = {1.000000000e+00f, 5.623413324e-01f, 3.162277639e-01f, 1.778279394e-01f, 1.000000015e-01f,
                          5.623413250e-02f, 3.162277490e-02f, 1.778279431e-02f, 9.999999776e-03f, 5.623413250e-03f,
                          3.162277630e-03f, 1.778279431e-03f, 1.000000047e-03f, 5.623413017e-04f, 3.162277571e-04f,
                          1.778279402e-04f};
  float* rc = (float*)(wsp(p) + OFF_ROPE);
  float* rsn = rc + 192 * 16;
  for (int i = threadIdx.x; i < 192 * 16; i += 512) {
    const int pi = i >> 4, f = i & 15;
    const int pos = pi < 128 ? pi : pi - 128;
    float fi = 1.f;
#pragma unroll
    for (int q = 0; q < 16; ++q) if (q == f) fi = invf[q];
    const float ang = (float)pos * fi;
    const double a = (double)ang;
    const double n = rint(a * 0.15915494309189535);
    const double r = a - n * 6.283185307179586476925;
    const double x = r * 0.25, x2 = x * x;
    const double sn = x * (1.0 + x2 * (-1.0 / 6 + x2 * (1.0 / 120 + x2 * (-1.0 / 5040 + x2 * (1.0 / 362880 + x2 * (-1.0 / 39916800 + x2 * (1.0 / 6227020800.0)))))));
    const double cs = 1.0 + x2 * (-0.5 + x2 * (1.0 / 24 + x2 * (-1.0 / 720 + x2 * (1.0 / 40320 + x2 * (-1.0 / 3628800 + x2 * (1.0 / 479001600.0 + x2 * (-1.0 / 87178291200.0)))))));
    const double s2 = 2 * sn * cs, c2 = cs * cs - sn * sn;
    rsn[i] = (float)(2 * s2 * c2);
    rc[i] = (float)(c2 * c2 - s2 * s2);
  }
}

__device__ __forceinline__ void phase_prep(const Params& p, char* smem) {
  int total = 0;
  for (int j = 0; j < NJOBS; ++j) { Job jb = get_job(p, j); total += (jb.Kpad >> 6) * (jb.Npad >> 6); }
  const int npair = (total + 1) >> 1;
  const int ntask = npair + 192 + 1;
  const int half = threadIdx.x >> 8;
  for (int t = blockIdx.x; t < ntask; t += gridDim.x) {
    if (t < npair) {
      int rem = 2 * t + half;
      const bool valid = rem < total;
      if (!valid) rem = total - 1;
      Job jb = get_job(p, 0);
      for (int j = 0; j < NJOBS; ++j) {
        jb = get_job(p, j);
        const int nt = (jb.Kpad >> 6) * (jb.Npad >> 6);
        if (rem < nt) break;
        rem -= nt;
      }
      transpose_tile(jb, rem, smem, valid);
    } else if (t < npair + 192) {
      mods_task(p, t - npair, smem);
    } else {
      rope_task(p);
    }
  }
}

__device__ __forceinline__ void load_row16(const float* row, int lane, float (&v)[16]) {
#pragma unroll
  for (int j = 0; j < 4; ++j) {
    const float4 f = *(const float4*)(row + j * 256 + lane * 4);
    v[4 * j] = f.x; v[4 * j + 1] = f.y; v[4 * j + 2] = f.z; v[4 * j + 3] = f.w;
  }
}
__device__ __forceinline__ void norm_mod16(float (&v)[16], const float* gn, const float* sh, const float* sc, int lane) {
  float ss = 0.f;
#pragma unroll
  for (int j = 0; j < 16; ++j) ss += v[j] * v[j];
  ss = red64(ss);
  const float rstd = rsqrtf(ss * (1.f / 1024.f) + 1e-6f);
#pragma unroll
  for (int j = 0; j < 4; ++j) {
    const int col = j * 256 + lane * 4;
    const float4 gv = *(const float4*)(gn + col), sv = *(const float4*)(sh + col), cv = *(const float4*)(sc + col);
    v[4 * j + 0] = v[4 * j + 0] * rstd * gv.x * (1.f + cv.x) + sv.x;
    v[4 * j + 1] = v[4 * j + 1] * rstd * gv.y * (1.f + cv.y) + sv.y;
    v[4 * j + 2] = v[4 * j + 2] * rstd * gv.z * (1.f + cv.z) + sv.z;
    v[4 * j + 3] = v[4 * j + 3] * rstd * gv.w * (1.f + cv.w) + sv.w;
  }
}
__device__ __forceinline__ void store_row16(u16* row, int lane, const float (&v)[16]) {
#pragma unroll
  for (int j = 0; j < 4; ++j) {
    uint2 w; w.x = pack2(v[4 * j], v[4 * j + 1]); w.y = pack2(v[4 * j + 2], v[4 * j + 3]);
    *(uint2*)(row + j * 256 + lane * 4) = w;
  }
}

__device__ __forceinline__ void phase_norm(const Params& p, int which) {
  const int lane = threadIdx.x & 63, wid = threadIdx.x >> 6;
  const int nrows = (which == 3) ? T_LAT : T_ALL;
  const int layer = (which == 3) ? 1 : 0;
  const float* mod = (const float*)(wsp(p) + OFF_MOD) + layer * 5 * 6144;
  const float* gn = (which == 0) ? inp(p, 6) : (inp(p, 7) + layer * 1024);
  const int shi = (which == 0) ? 0 : 3;
  const float* srcL = (which == 0) ? inp(p, 0) : outp(p);
  const float* srcC = (which == 0) ? inp(p, 2) : (const float*)(wsp(p) + OFF_CTXR);
  u16* dst = (u16*)(wsp(p) + ((which == 1) ? OFF_F : OFF_A));
  for (int t = blockIdx.x * 8 + wid; t < nrows; t += gridDim.x * 8) {
    const float* src; int gb;
    if (t < T_LAT) { src = srcL + (size_t)t * 1024; gb = t >> 13; } else { src = srcC + (size_t)(t - T_LAT) * 1024; gb = 4; }
    float v[16];
    load_row16(src, lane, v);
    norm_mod16(v, gn, mod + gb * 6144 + shi * 1024, mod + gb * 6144 + (shi + 1) * 1024, lane);
    store_row16(dst + (size_t)t * 1024, lane, v);
  }
}

__device__ __forceinline__ void phase_norm_shift(const Params& p) {
  const int lane = threadIdx.x & 63, wid = threadIdx.x >> 6;
  const float* mod = (const float*)(wsp(p) + OFF_MOD) + 5 * 6144;
  const float* gn = inp(p, 6) + 1024;
  u16* h1 = (u16*)(wsp(p) + OFF_A);
  u16* xx = (u16*)(wsp(p) + OFF_B);
  for (int t = blockIdx.x * 8 + wid; t < T_ALL; t += gridDim.x * 8) {
    const float* src; int gb, s, L;
    if (t < T_LAT) { src = outp(p) + (size_t)t * 1024; gb = t >> 13; s = t & 8191; L = 8192; }
    else { src = (const float*)(wsp(p) + OFF_CTXR) + (size_t)(t - T_LAT) * 1024; gb = 4; s = (t - T_LAT) & 255; L = 256; }
    const float* sh = mod + gb * 6144; const float* sc = sh + 1024;
    float v[16], a[16], b[16];
    load_row16(src, lane, v);
    norm_mod16(v, gn, sh, sc, lane);
    if (s > 0) { load_row16(src - 1024, lane, a); norm_mod16(a, gn, sh, sc, lane); }
    else {
#pragma unroll
      for (int j = 0; j < 16; ++j) a[j] = 0.f;
    }
    if (s < L - 1) { load_row16(src + 1024, lane, b); norm_mod16(b, gn, sh, sc, lane); }
    else {
#pragma unroll
      for (int j = 0; j < 16; ++j) b[j] = 0.f;
    }
#pragma unroll
    for (int j = 0; j < 16; ++j) a[j] = 0.5f * (a[j] + b[j]) - v[j];
    store_row16(h1 + (size_t)t * 1024, lane, v);
    store_row16(xx + (size_t)t * 1024, lane, a);
  }
}

__device__ __forceinline__ void attn_task(const Params& p, char* smem, int task) {
  const int tid = threadIdx.x, lane = tid & 63, wid = tid >> 6, lr = lane & 31, g = lane >> 5;
  const u16* Ql = (const u16*)(wsp(p) + OFF_C);
  const u16* Qc = Ql + (size_t)32 * 8192 * 192;
  const u16* Kb = (const u16*)(wsp(p) + OFF_C + 99 * MiB);
  const u16* Vt = (const u16*)(wsp(p) + OFF_B);
  u16* AO = (u16*)(wsp(p) + OFF_A);
  int bh, nkt; const u16* Qp; size_t tok0;
  if (task < 1024) { bh = task >> 5; const int q0 = (task & 31) * 256; nkt = 264; Qp = Ql + ((size_t)bh * 8192 + q0) * 192; tok0 = (size_t)(bh >> 3) * 8192 + q0; }
  else { bh = task - 1024; nkt = 8; Qp = Qc + (size_t)bh * 256 * 192; tok0 = (size_t)T_LAT + (bh >> 3) * 256; }
  const u16* Kp = Kb + (size_t)bh * 8448 * 192;
  const u16* Vp = Vt + (size_t)bh * 128 * 8448;
  bf16x8 qf[12];
#pragma unroll
  for (int ks = 0; ks < 12; ++ks) qf[ks] = *(const bf16x8*)(Qp + (size_t)(wid * 32 + lr) * 192 + ks * 16 + g * 8);
  f32x16 O[4];
#pragma unroll
  for (int dt = 0; dt < 4; ++dt)
#pragma unroll
    for (int i = 0; i < 16; ++i) O[dt][i] = 0.f;
  float m = -1e30f, l = 0.f;
  constexpr int KBYTES = 32 * 384, ASTAGE = KBYTES + 128 * 64;
  const int wu = __builtin_amdgcn_readfirstlane(wid);
  const bool kwave = wu < 4;
  unsigned gp[3];
  const __amdgpu_buffer_rsrc_t rsKV = __builtin_amdgcn_make_buffer_rsrc((void*)(kwave ? Kp : Vp), 0, 0x7fffffff, 0x00020000);
#pragma unroll
  for (int i = 0; i < 3; ++i) {
    if (kwave) {
      const int o = (i * 4 + wu) * 1024 + lane * 16;
      const int row = o / 384, pos = (o - row * 384) >> 4;
      const int c = (pos & ~7) | ((pos & 7) ^ ((row >> 1) & 7));
      gp[i] = (unsigned)(row * 192 + c * 8) * 2u;
    } else {
      const int row = ((i & 1) * 4 + (wu - 4)) * 16 + (lane >> 2);
      const int c = (lane & 3) ^ ((row >> 2) & 3);
      gp[i] = (unsigned)(row * 8448 + c * 8) * 2u;
    }
  }
#define ATT_STAGE(BUF, J)                                                                                            \
  {                                                                                                                  \
    if (kwave) {                                                                                                     \
      _Pragma("unroll") for (int i = 0; i < 3; ++i) __builtin_amdgcn_raw_ptr_buffer_load_lds(                        \
          rsKV, (LAS void*)(smem + (BUF) * ASTAGE + (i * 4 + wu) * 1024), 16, gp[i], (J) * (32 * 192 * 2), 0, 0);    \
    } else {                                                                                                         \
      _Pragma("unroll") for (int i = 0; i < 2; ++i) __builtin_amdgcn_raw_ptr_buffer_load_lds(                        \
          rsKV, (LAS void*)(smem + (BUF) * ASTAGE + KBYTES + (i * 4 + wu - 4) * 1024), 16, gp[i], (J) * 64, 0, 0);   \
    }                                                                                                                \
  }
  const int ksw = (lr >> 1) & 7, vsw = (lr >> 2) & 3;
  WAIT_V(0);
  __syncthreads();
  ATT_STAGE(0, 0)
  if (nkt > 1) ATT_STAGE(1, 1)
  int cur = 0, nxt = 2;
  for (int j = 0; j < nkt; ++j) {
    if (j + 1 < nkt) { if (kwave) WAIT_V(3); else WAIT_V(2); } else WAIT_V(0);
    lds_barrier();
    if (j + 2 < nkt) ATT_STAGE(nxt, j + 2)
    const char* Kc = smem + cur * ASTAGE;
    const char* Vc = Kc + KBYTES;
    cur = (cur == 2) ? 0 : cur + 1;
    nxt = (nxt == 2) ? 0 : nxt + 1;
    f32x16 s0;
#pragma unroll
    for (int i = 0; i < 16; ++i) s0[i] = 0.f;
#pragma unroll
    for (int ks = 0; ks < 12; ++ks) {
      const int kc = ks * 2 + g;
      bf16x8 a0 = *(const bf16x8*)(Kc + lr * 384 + (((kc & ~7) | ((kc & 7) ^ ksw)) << 4));
      s0 = mfma32(a0, qf[ks], s0);
    }
    if ((j & 3) == 0) {
      float mx = s0[0];
#pragma unroll
      for (int i = 1; i < 16; ++i) mx = fmaxf(mx, s0[i]);
      mx = max_x32(mx);
      if (__builtin_amdgcn_ballot_w64(mx > m + 8.0f) != 0ull) {
        const float mn = fmaxf(m, mx);
        const float alpha = __builtin_amdgcn_exp2f(m - mn);
        m = mn;
        l *= alpha;
#pragma unroll
        for (int dt = 0; dt < 4; ++dt)
#pragma unroll
          for (int i = 0; i < 16; ++i) O[dt][i] *= alpha;
      }
    }
    float ps = 0.f;
#pragma unroll
    for (int i = 0; i < 16; ++i) { s0[i] = __builtin_amdgcn_exp2f(s0[i] - m); ps += s0[i]; }
    l += ps;
    bf16x8 pf[2];
    {
      u32x4 w;
      w[0] = pack2(s0[0], s0[1]); w[1] = pack2(s0[2], s0[3]); w[2] = pack2(s0[4], s0[5]); w[3] = pack2(s0[6], s0[7]);
      pf[0] = __builtin_bit_cast(bf16x8, w);
      w[0] = pack2(s0[8], s0[9]); w[1] = pack2(s0[10], s0[11]); w[2] = pack2(s0[12], s0[13]); w[3] = pack2(s0[14], s0[15]);
      pf[1] = __builtin_bit_cast(bf16x8, w);
    }
#pragma unroll
    for (int dt = 0; dt < 4; ++dt) {
#pragma unroll
      for (int kk = 0; kk < 2; ++kk) {
        bf16x8 vf = *(const bf16x8*)(Vc + (dt * 32 + lr) * 64 + (((kk * 2 + g) ^ vsw) << 4));
        O[dt] = mfma32(vf, pf[kk], O[dt]);
      }
    }
  }
#undef ATT_STAGE
  l += __shfl_xor(l, 32);
  const float inv = 1.f / l;
  {
    const __amdgpu_buffer_rsrc_t rsO = __builtin_amdgcn_make_buffer_rsrc((void*)AO, 0, 0x7fffffff, 0x00020000);
    const int voff = (lr * 1024 + 4 * g) * 2;
    const int sbase = ((int)(tok0 + wu * 32) * 1024 + (bh & 7) * 128) * 2;
#pragma unroll
    for (int dt = 0; dt < 4; ++dt)
#pragma unroll
      for (int a2 = 0; a2 < 4; ++a2) {
        typedef unsigned u32x2 __attribute__((ext_vector_type(2)));
        u32x2 w;
        w[0] = pack2(O[dt][4 * a2] * inv, O[dt][4 * a2 + 1] * inv);
        w[1] = pack2(O[dt][4 * a2 + 2] * inv, O[dt][4 * a2 + 3] * inv);
        __builtin_amdgcn_raw_buffer_store_b64(w, rsO, voff, sbase + (dt * 32 + 8 * a2) * 2, 0);
      }
  }
}

template <int LPR>
__device__ __forceinline__ float red_lpr(float v) {
  if (LPR == 16) return red16(v);
  return red8(v);
}

template <int LPR>
__device__ __forceinline__ void scan_task(const Params& p, char* smem, int task) {
  constexpr int ROWS = 512 / LPR, EPT = 64 / LPR, NSPLIT = 64 / ROWS;
  constexpr int NST = 32;
  constexpr int NYK = NST / LPR;
  float* Wd = (float*)smem;
  float* KD = Wd + NST * 64; float* AA = KD + NST * 64; float* BB = AA + NST * 64; float* RR = BB + NST * 64;
  float* VV = RR + NST * 64; float* AS = VV + NST * 64; float* YO = AS + NST * 64;
  const int chain = task / NSPLIT, hv = task % NSPLIT;
  const int d = chain & 1, bh = chain >> 1, b = bh >> 4, h = bh & 15;
  const int tid = threadIdx.x, lane = tid & 63;
  const int wid = __builtin_amdgcn_readfirstlane(tid >> 6);
  const int msel = wid & 1, ntb = wid >> 1;
  const u16* W = (const u16*)(wsp(p) + OFF_W);
  const u16* rbuf = (const u16*)(wsp(p) + OFF_C);
  const u16* kbuf = rbuf + (size_t)T_ALL * 1024;
  const u16* vbuf = kbuf + (size_t)T_ALL * 1024;
  const u16* hidw = (const u16*)(wsp(p) + OFF_E);
  const u16* hida = hidw + (size_t)T_ALL * 128;
  u16* ybuf = (u16*)(wsp(p) + (d ? OFF_B : OFF_A));
  float* bonus = (float*)(wsp(p) + OFF_BONUS) + (size_t)d * T_LAT * 16;
  bf16x8 wb[1][2];
  float biasv[1];
  const u16* hid = msel ? hida : hidw;
  {
    const u16* W2 = W + (msel ? W_IA2 : W_DW2) + (size_t)d * 65536;
    const float* bias = (msel ? inp(p, 30) : inp(p, 27)) + d * 1024;
#pragma unroll
    for (int n2 = 0; n2 < 1; ++n2) {
#pragma unroll
      for (int ks = 0; ks < 2; ++ks)
        wb[n2][ks] = *(const bf16x8*)(W2 + (size_t)(h * 64 + (ntb + n2) * 16 + (lane & 15)) * 64 + ks * 32 + (lane >> 4) * 8);
      biasv[n2] = bias[h * 64 + (ntb + n2) * 16 + (lane & 15)];
    }
  }
  const int st2 = tid >> 4, c4 = (tid & 15) * 4;
  float* CK = YO + NST * ROWS * LPR;
  if (tid < 192) {
    const int which = tid >> 6, ch = tid & 63;
    const float* src = (which == 0) ? inp(p, 24) : (which == 1) ? inp(p, 25) : inp(p, 26);
    CK[tid] = src[h * 64 + ch];
  }
  const int vrow = tid / LPR, part = tid % LPR;
  float S[EPT];
#pragma unroll
  for (int j = 0; j < EPT; ++j) S[j] = 0.f;
  auto tok = [&](int i) -> int {
    if (i < 256) return T_LAT + b * 256 + (d ? 255 - i : i);
    const int s = i - 256;
    return b * 8192 + (d ? 8191 - s : s);
  };
  bf16x8 na[2][2]; uint2 nk1, nv1, nr1;
  auto prefetch = [&](int i0) {
#pragma unroll
    for (int hf = 0; hf < 2; ++hf) {
      const int t = tok(i0 + hf * 16 + (lane & 15));
#pragma unroll
      for (int ks = 0; ks < 2; ++ks) na[hf][ks] = *(const bf16x8*)(hid + (size_t)t * 128 + d * 64 + ks * 32 + (lane >> 4) * 8);
    }
    const int t2 = tok(i0 + st2);
    const size_t o = (size_t)t2 * 1024 + h * 64 + c4;
    nk1 = *(const uint2*)(kbuf + o); nv1 = *(const uint2*)(vbuf + o); nr1 = *(const uint2*)(rbuf + o);
  };
  prefetch(0);
  __syncthreads();
  constexpr int NSTG = 8448 / NST;
  for (int stg = 0; stg < NSTG; ++stg) {
    const int i0 = stg * NST;
    {
      float* dstp = msel ? AS : Wd;
#pragma unroll
      for (int hf = 0; hf < 2; ++hf) {
        f32x4 acc[1];
#pragma unroll
        for (int n2 = 0; n2 < 1; ++n2) { acc[n2][0] = 0.f; acc[n2][1] = 0.f; acc[n2][2] = 0.f; acc[n2][3] = 0.f; }
#pragma unroll
        for (int ks = 0; ks < 2; ++ks)
#pragma unroll
          for (int n2 = 0; n2 < 1; ++n2) acc[n2] = mfma16(na[hf][ks], wb[n2][ks], acc[n2]);
#pragma unroll
        for (int n2 = 0; n2 < 1; ++n2)
#pragma unroll
          for (int i = 0; i < 4; ++i) {
            const int step = hf * 16 + (lane >> 4) * 4 + i, ch = (ntb + n2) * 16 + (lane & 15);
            const float sg = sigmoid_f(acc[n2][i] + biasv[n2]);
            dstp[step * 64 + ch] = msel ? sg : __expf(-0.6065306597126334f * sg);
          }
      }
    }
    lds_barrier();
    {
      const int stp = st2;
      const int t2 = tok(i0 + stp);
      float kr[4] = {lo2f(nk1.x), hi2f(nk1.x), lo2f(nk1.y), hi2f(nk1.y)};
      float vr[4] = {lo2f(nv1.x), hi2f(nv1.x), lo2f(nv1.y), hi2f(nv1.y)};
      float rr[4] = {lo2f(nr1.x), hi2f(nr1.x), lo2f(nr1.y), hi2f(nr1.y)};
      const float4 av = *(const float4*)(AS + stp * 64 + c4);
      float a[4] = {av.x, av.y, av.z, av.w};
      const float4 c0 = *(const float4*)(CK + c4), c1 = *(const float4*)(CK + 64 + c4), c2 = *(const float4*)(CK + 128 + c4);
      const float kkc[4] = {c0.x, c0.y, c0.z, c0.w}, kac[4] = {c1.x, c1.y, c1.z, c1.w}, rkc[4] = {c2.x, c2.y, c2.z, c2.w};
      float kk[4], ss = 0.f;
#pragma unroll
      for (int j = 0; j < 4; ++j) { kk[j] = kr[j] * kkc[j]; ss += kk[j] * kk[j]; }
      ss = red16(ss);
      const float inv = rsqrtf(ss + 1e-12f);
      float bon = 0.f;
      float o_aa[4], o_bb[4], o_kd[4];
#pragma unroll
      for (int j = 0; j < 4; ++j) {
        const float kn = kk[j] * inv;
        o_aa[j] = -kn; o_bb[j] = kn * a[j];
        o_kd[j] = kr[j] * (1.f + (a[j] - 1.f) * kac[j]);
        bon += rr[j] * o_kd[j] * rkc[j];
      }
      bon = red16(bon);
      *(float4*)(AA + stp * 64 + c4) = make_float4(o_aa[0], o_aa[1], o_aa[2], o_aa[3]);
      *(float4*)(BB + stp * 64 + c4) = make_float4(o_bb[0], o_bb[1], o_bb[2], o_bb[3]);
      *(float4*)(KD + stp * 64 + c4) = make_float4(o_kd[0], o_kd[1], o_kd[2], o_kd[3]);
      *(float4*)(RR + stp * 64 + c4) = make_float4(rr[0], rr[1], rr[2], rr[3]);
      *(float4*)(VV + stp * 64 + c4) = make_float4(vr[0], vr[1], vr[2], vr[3]);
      if ((tid & 15) == 0 && hv == 0 && t2 < T_LAT) bonus[(size_t)t2 * 16 + h] = bon;
    }
    lds_barrier();
    if (stg + 1 < NSTG) prefetch(i0 + NST);
    float xa[EPT], xw[EPT], xb[EPT], xk[EPT], xr[EPT], xv;
    float za[EPT], zw[EPT], zb[EPT], zk[EPT], zr[EPT], zv;
    float yk[NYK];
#pragma unroll
    for (int q = 0; q < NYK; ++q) yk[q] = 0.f;
#define SCAN_LD(ST, XA, XW, XB, XK, XR, XV)                                     \
    {                                                                            \
      _Pragma("unroll") for (int q = 0; q < EPT / 4; ++q) {                      \
        const float4 t0 = *(const float4*)(AA + (ST) * 64 + part * EPT + 4 * q); \
        const float4 t1 = *(const float4*)(Wd + (ST) * 64 + part * EPT + 4 * q); \
        const float4 t2 = *(const float4*)(BB + (ST) * 64 + part * EPT + 4 * q); \
        const float4 t3 = *(const float4*)(KD + (ST) * 64 + part * EPT + 4 * q); \
        const float4 t4 = *(const float4*)(RR + (ST) * 64 + part * EPT + 4 * q); \
        XA[4 * q] = t0.x; XA[4 * q + 1] = t0.y; XA[4 * q + 2] = t0.z; XA[4 * q + 3] = t0.w; \
        XW[4 * q] = t1.x; XW[4 * q + 1] = t1.y; XW[4 * q + 2] = t1.z; XW[4 * q + 3] = t1.w; \
        XB[4 * q] = t2.x; XB[4 * q + 1] = t2.y; XB[4 * q + 2] = t2.z; XB[4 * q + 3] = t2.w; \
        XK[4 * q] = t3.x; XK[4 * q + 1] = t3.y; XK[4 * q + 2] = t3.z; XK[4 * q + 3] = t3.w; \
        XR[4 * q] = t4.x; XR[4 * q + 1] = t4.y; XR[4 * q + 2] = t4.z; XR[4 * q + 3] = t4.w; \
      }                                                                          \
      XV = VV[(ST) * 64 + hv * ROWS + vrow];                                     \
    }
#define SCAN_STEP(ST, XA, XW, XB, XK, XR, XV)                                    \
    {                                                                            \
      float pr_[EPT], sw_[EPT];                                                  \
      _Pragma("unroll") for (int j = 0; j < EPT; ++j) { pr_[j] = S[j] * XA[j]; sw_[j] = S[j] * XW[j] + XV * XK[j]; } \
      _Pragma("unroll") for (int w_ = EPT / 2; w_ >= 1; w_ >>= 1)               \
        _Pragma("unroll") for (int j = 0; j < w_; ++j) pr_[j] += pr_[j + w_];    \
      const float sa = red_lpr<LPR>(pr_[0]);                                     \
      _Pragma("unroll") for (int j = 0; j < EPT; ++j) { S[j] = sa * XB[j] + sw_[j]; pr_[j] = S[j] * XR[j]; } \
      _Pragma("unroll") for (int w_ = EPT / 2; w_ >= 1; w_ >>= 1)               \
        _Pragma("unroll") for (int j = 0; j < w_; ++j) pr_[j] += pr_[j + w_];    \
      YO[((ST) * ROWS + vrow) * LPR + part] = pr_[0];                            \
    }
    SCAN_LD(0, xa, xw, xb, xk, xr, xv)
#pragma unroll 2
    for (int st = 0; st < NST; st += 2) {
      SCAN_LD(st + 1, za, zw, zb, zk, zr, zv)
      SCAN_STEP(st, xa, xw, xb, xk, xr, xv)
      if (st + 2 < NST) SCAN_LD(st + 2, xa, xw, xb, xk, xr, xv)
      SCAN_STEP(st + 1, za, zw, zb, zk, zr, zv)
    }
#undef SCAN_LD
#undef SCAN_STEP
    lds_barrier();
    if (i0 >= 256) {
      for (int e = tid; e < NST * ROWS / 2; e += 512) {
        const int st = e / (ROWS / 2), pr = (e % (ROWS / 2)) * 2;
        const int t = tok(i0 + st);
        float ysum[2];
#pragma unroll
        for (int u = 0; u < 2; ++u) {
          const float* yp = YO + (st * ROWS + pr + u) * LPR;
          float acc_ = 0.f;
#pragma unroll
          for (int q = 0; q < LPR / 4; ++q) { const float4 f = *(const float4*)(yp + 4 * q); acc_ += (f.x + f.y) + (f.z + f.w); }
          ysum[u] = acc_;
        }
        *(unsigned*)(ybuf + (size_t)t * 1024 + h * 64 + hv * ROWS + pr) = pack2(ysum[0], ysum[1]);
      }
    }
  }
}

__device__ __forceinline__ void phase_rwkv_out(const Params& p) {
  const int lane = threadIdx.x & 63, wid = threadIdx.x >> 6;
  const u16* yf = (const u16*)(wsp(p) + OFF_A);
  const u16* yb = (const u16*)(wsp(p) + OFF_B);
  const u16* vbuf = (const u16*)(wsp(p) + OFF_C) + (size_t)2 * T_ALL * 1024;
  const u16* gbuf = (const u16*)(wsp(p) + OFF_F);
  const float* bonus = (const float*)(wsp(p) + OFF_BONUS);
  u16* oin = (u16*)(wsp(p) + OFF_C);
  const int ch0 = lane * 16, head = lane >> 2;
  float gw[16], gb[16];
#pragma unroll
  for (int j = 0; j < 16; ++j) { gw[j] = inp(p, 35)[ch0 + j]; gb[j] = inp(p, 36)[ch0 + j]; }
  for (int t = blockIdx.x * 8 + wid; t < T_LAT; t += gridDim.x * 8) {
    const size_t o = (size_t)t * 1024 + ch0;
    uint4 a0 = *(const uint4*)(yf + o), a1 = *(const uint4*)(yf + o + 8);
    uint4 b0 = *(const uint4*)(yb + o), b1 = *(const uint4*)(yb + o + 8);
    uint4 v0 = *(const uint4*)(vbuf + o), v1 = *(const uint4*)(vbuf + o + 8);
    uint4 g0 = *(const uint4*)(gbuf + o), g1 = *(const uint4*)(gbuf + o + 8);
    const unsigned ya[8] = {a0.x, a0.y, a0.z, a0.w, a1.x, a1.y, a1.z, a1.w};
    const unsigned yb8[8] = {b0.x, b0.y, b0.z, b0.w, b1.x, b1.y, b1.z, b1.w};
    const unsigned vv[8] = {v0.x, v0.y, v0.z, v0.w, v1.x, v1.y, v1.z, v1.w};
    const unsigned gg[8] = {g0.x, g0.y, g0.z, g0.w, g1.x, g1.y, g1.z, g1.w};
    float y[16];
    float s = 0.f;
#pragma unroll
    for (int j = 0; j < 8; ++j) { y[2 * j] = lo2f(ya[j]) + lo2f(yb8[j]); y[2 * j + 1] = hi2f(ya[j]) + hi2f(yb8[j]); s += y[2 * j] + y[2 * j + 1]; }
    s = red4(s);
    const float mu = s * (1.f / 64.f);
    float q = 0.f;
#pragma unroll
    for (int j = 0; j < 16; ++j) { const float dlt = y[j] - mu; q += dlt * dlt; }
    q = red4(q);
    const float rstd = rsqrtf(q * (1.f / 64.f) + 64e-5f);
    const float bon = bonus[(size_t)t * 16 + head] + bonus[(size_t)T_LAT * 16 + (size_t)t * 16 + head];
    unsigned w[8];
#pragma unroll
    for (int j = 0; j < 8; ++j) {
      const float o0 = ((y[2 * j] - mu) * rstd * gw[2 * j] + gb[2 * j] + bon * lo2f(vv[j])) * lo2f(gg[j]);
      const float o1 = ((y[2 * j + 1] - mu) * rstd * gw[2 * j + 1] + gb[2 * j + 1] + bon * hi2f(vv[j])) * hi2f(gg[j]);
      w[j] = pack2(o0, o1);
    }
    *(uint4*)(oin + o) = make_uint4(w[0], w[1], w[2], w[3]);
    *(uint4*)(oin + o + 8) = make_uint4(w[4], w[5], w[6], w[7]);
  }
}

__device__ __forceinline__ void tile_map(int t, int total, int ntn, int& mt, int& nt) {
  const int q = total >> 3, r8 = total & 7, xcd = t & 7, off = t >> 3;
  const int v = (xcd < r8 ? xcd * (q + 1) : r8 * (q + 1) + (xcd - r8) * q) + off;
  const int pw = 4 * ntn;
  const int panel = v / pw, r = v - panel * pw;
  nt = r >> 2;
  mt = panel * 4 + (r & 3);
}

#define XB_TMO      128
#define XB_XCNT(j)  (256  + 64 * (j))
#define XB_XSUB(j)  (1280 + 64 * (j))
#define XB_XGEN(j)  (2304 + 64 * (j))
#define XB_TOP      3328
#define XB_TOPGEN   3392
#define XCD_BAR_WORDS 3456
#define XB_SPIN_CAP (1u << 20)
__device__ __forceinline__ unsigned xb_ld(unsigned* p) { return __hip_atomic_load(p, __ATOMIC_RELAXED, __HIP_MEMORY_SCOPE_AGENT); }
__device__ __forceinline__ unsigned xb_add(unsigned* p, unsigned v) { return __hip_atomic_fetch_add(p, v, __ATOMIC_RELAXED, __HIP_MEMORY_SCOPE_AGENT); }
__device__ __forceinline__ unsigned xb_xcc_id() { return (unsigned)__builtin_amdgcn_s_getreg((3 << 11) | 20) & 0xFu; }
#define XB_SPIN(cond, bar) do { unsigned _sp = 0; while (cond) { __builtin_amdgcn_s_sleep(1); \
    if ((++_sp & 255u) == 0u) { if (xb_ld(&(bar)[XB_TMO])) break; if (_sp > XB_SPIN_CAP) { atomicAdd(&(bar)[XB_TMO], 1u); break; } } } } while (0)
struct XcdBarrier { unsigned* bar; unsigned x; volatile LAS unsigned* st; };
__device__ __forceinline__ XcdBarrier xcd_barrier_post(unsigned* bar, volatile LAS unsigned* st) {
  XcdBarrier b; b.bar = bar; b.x = xb_xcc_id(); b.st = st;
  if (threadIdx.x == 0) (void)xb_add(&bar[XB_XCNT(b.x)], 1u);
  return b;
}
__device__ __forceinline__ void xcd_barrier_complete(unsigned* bar, unsigned x, unsigned& nloc, unsigned& nx) {
  const unsigned G = gridDim.x * gridDim.y * gridDim.z;
  unsigned sum, cnt, mine, sp = 0u;
  for (;;) {
    sum = 0u; cnt = 0u; mine = 0u;
#pragma unroll
    for (unsigned j = 0; j < 16; ++j) { const unsigned c = xb_ld(&bar[XB_XCNT(j)]); sum += c; cnt += (c > 0u) ? 1u : 0u; mine = (j == x) ? c : mine; }
    if (sum == G) break;
    __builtin_amdgcn_s_sleep(1);
    if ((++sp & 255u) == 0u) { if (xb_ld(&bar[XB_TMO])) break; if (sp > XB_SPIN_CAP) { atomicAdd(&bar[XB_TMO], 1u); break; } }
  }
  nloc = mine > 0u ? mine : 1u; nx = cnt > 0u ? cnt : 1u;
}
__device__ __forceinline__ void xcd_barrier(const XcdBarrier& b) {
  asm volatile("s_waitcnt vmcnt(0)" ::: "memory");
  __syncthreads();
  if (threadIdx.x == 0) {
    unsigned* bar = b.bar;
    __builtin_amdgcn_s_waitcnt(0);
    unsigned nloc = b.st[0], nx = b.st[1];
    if (nloc == 0u) { xcd_barrier_complete(bar, b.x, nloc, nx); b.st[0] = nloc; b.st[1] = nx; }
    const unsigned old = xb_add(&bar[XB_XSUB(b.x)], 1u);
    const unsigned gen = old / nloc;
    if (old + 1u == (gen + 1u) * nloc) {
      __builtin_amdgcn_fence(__ATOMIC_RELEASE, "agent");
      asm volatile("s_waitcnt vmcnt(0)" ::: "memory");
      const unsigned og = xb_add(&bar[XB_TOP], 1u);
      const unsigned tg = og / nx;
      if (og + 1u == (tg + 1u) * nx) xb_add(&bar[XB_TOPGEN], 1u);
      else XB_SPIN(xb_ld(&bar[XB_TOPGEN]) == tg, bar);
      __builtin_amdgcn_fence(__ATOMIC_ACQUIRE, "agent");
      xb_add(&bar[XB_XGEN(b.x)], 1u);
      asm volatile("s_waitcnt vmcnt(0)" ::: "memory");
    } else {
      XB_SPIN(xb_ld(&bar[XB_XGEN(b.x)]) == gen, bar);
      __builtin_amdgcn_fence(__ATOMIC_ACQUIRE, "agent");
      asm volatile("s_waitcnt vmcnt(0)" ::: "memory");
    }
  }
  __syncthreads();
}

constexpr int NPH = 17;
constexpr int SMEM_BYTES = 131072;

__global__ void __launch_bounds__(512, 2) mega(Params p, int ph_lo, int ph_hi, int coop) {
  __shared__ __attribute__((aligned(1024))) char smem[SMEM_BYTES + 16];
  if (threadIdx.x == 0) { *(volatile LAS unsigned*)(smem + SMEM_BYTES) = 0u; *(volatile LAS unsigned*)(smem + SMEM_BYTES + 4) = 0u; }
  __syncthreads();
  const XcdBarrier xb = xcd_barrier_post((unsigned*)(wsp(p) + OFF_BAR), (volatile LAS unsigned*)(smem + SMEM_BYTES));
  const u16* W = (const u16*)(wsp(p) + OFF_W);
  float* mod = (float*)(wsp(p) + OFF_MOD);
  const float* ropec = (const float*)(wsp(p) + OFF_ROPE);
  const float* ropes = ropec + 192 * 16;
  float* ssp = (float*)(wsp(p) + OFF_SSP);
  float* krope = (float*)(wsp(p) + OFF_KROPE);
  float* ctxr = (float*)(wsp(p) + OFF_CTXR);
#ifndef ONLY_PH
#define PH_SEL(n) true
#else
#define PH_SEL(n) ((n) == ONLY_PH)
#endif
#define PH_BEGIN(n) if (PH_SEL(n) && ph_lo <= (n) && (n) < ph_hi) {
#define PH_END(n) } if (coop && ph_lo <= (n) && (n) + 1 < ph_hi) { if (coop == 2) cg::this_grid().sync(); else xcd_barrier(xb); }
  {
    {
      PH_BEGIN(0) phase_prep(p, smem); PH_END(0)
      PH_BEGIN(1) phase_norm(p, 0); PH_END(1)
      PH_BEGIN(2) {
        EpDown ep{(u16*)(wsp(p) + OFF_F), krope, ssp};
        for (int t = blockIdx.x; t < 132 * 3; t += gridDim.x) {
          int mt, nt; tile_map(t, 132 * 3, 3, mt, nt);
          gemm_tile_w8<4>(smem, (const u16*)(wsp(p) + OFF_A), 1024, W + W_DQ, 1024, 704, 1024, mt * 256, nt * 256, ep);
        }
      } PH_END(2)
      PH_BEGIN(3) {
        u16* Ql = (u16*)(wsp(p) + OFF_C);
        EpQ epq{Ql, Ql + (size_t)32 * 8192 * 192, ssp, inp(p, 16), ropec, ropes};
        EpKV epk{(u16*)(wsp(p) + OFF_C + 99 * MiB), (u16*)(wsp(p) + OFF_B), ssp, krope, inp(p, 17), ropec, ropes};
        ALPlain alq{(const u16*)(wsp(p) + OFF_F), 640};
        for (int t = blockIdx.x; t < 132 * 16; t += gridDim.x) {
          int mt, r; tile_map(t, 132 * 16, 16, mt, r);
          if (r < 8) gemm_tile<6, 64>(smem, alq, W + W_UQ, 384, 1536, 384, mt * 256, r * 192, epq);
          else gemm_tile_w8<4>(smem, (const u16*)(wsp(p) + OFF_F) + 384, 640, W + W_UKV, 256, 2048, 256, mt * 256, (r - 8) * 256, epk);
        }
      } PH_END(3)
      PH_BEGIN(4) {
        for (int t = blockIdx.x; t < 1056; t += gridDim.x) attn_task(p, smem, t < 1024 ? ((t & 7) * 128 + (t >> 3)) : t);
      } PH_END(4)
      PH_BEGIN(5) {
        EpRes ep{inp(p, 0), inp(p, 2), outp(p), ctxr, mod + 2 * 1024};
        for (int t = blockIdx.x; t < 132 * 8; t += gridDim.x) {
          int mt, nt; tile_map(t, 132 * 8, 8, mt, nt);
          gemm_tile_w8<2>(smem, (const u16*)(wsp(p) + OFF_A), 1024, W + W_O0, 1024, 1024, 1024, mt * 256, nt * 128, ep);
        }
      } PH_END(5)
      PH_BEGIN(6) phase_norm(p, 1); PH_END(6)
      PH_BEGIN(7) {
        EpFfn1 ep{(u16*)(wsp(p) + OFF_C)};
        for (int t = blockIdx.x; t < 132 * 22; t += gridDim.x) {
          int mt, nt; tile_map(t, 132 * 22, 22, mt, nt);
          gemm_tile_w8<4>(smem, (const u16*)(wsp(p) + OFF_F), 1024, W + W_13, 1024, 5632, 1024, mt * 256, nt * 256, ep);
        }
      } PH_END(7)
      PH_BEGIN(8) {
        EpRes ep{outp(p), ctxr, outp(p), ctxr, mod + 5 * 1024};
        for (int t = blockIdx.x; t < 132 * 8; t += gridDim.x) {
          int mt, nt; tile_map(t, 132 * 8, 8, mt, nt);
          gemm_tile_w8<2>(smem, (const u16*)(wsp(p) + OFF_C), DFF, W + W_2, DFF, 1024, DFF, mt * 256, nt * 128, ep);
        }
      } PH_END(8)
      PH_BEGIN(9) phase_norm_shift(p); PH_END(9)
      PH_BEGIN(10) {
        u16* rbuf = (u16*)(wsp(p) + OFF_C);
        u16* hidw = (u16*)(wsp(p) + OFF_E);
        EpRw1 ep{rbuf, rbuf + (size_t)T_ALL * 1024, rbuf + (size_t)2 * T_ALL * 1024, hidw, hidw + (size_t)T_ALL * 128, hidw + (size_t)2 * T_ALL * 128};
        for (int t = blockIdx.x; t < 132 * 14; t += gridDim.x) {
          int mt, nt; tile_map(t, 132 * 14, 14, mt, nt);
          const int c0 = nt * 256;
          const int mi = c0 < 1024 ? 0 : c0 < 2048 ? 2 : c0 < 3072 ? 3 : c0 < 3328 ? -1 : 5;
          if (mi >= 0) {
            gemm_tile_w8m(smem, (const u16*)(wsp(p) + OFF_A), (const u16*)(wsp(p) + OFF_B), inp(p, 19) + mi * 1024, W + W_P1, 1024, 1024, mt * 256, c0, ep);
          } else {
            ALMix al1{(const u16*)(wsp(p) + OFF_A), (const u16*)(wsp(p) + OFF_B), inp(p, 19) + 1 * 1024};
            gemm_tile<4, 64>(smem, al1, W + W_P1, 1024, 3584, 1024, mt * 256, 3072, ep);
            ALMix al4{(const u16*)(wsp(p) + OFF_A), (const u16*)(wsp(p) + OFF_B), inp(p, 19) + 4 * 1024};
            gemm_tile<4, 64>(smem, al4, W + W_P1, 1024, 3584, 1024, mt * 256, 3200, ep);
          }
        }
      } PH_END(10)
      PH_BEGIN(11) {
        EpPlain ep{(u16*)(wsp(p) + OFF_F), 1024};
        for (int t = blockIdx.x; t < 256 + 128 * 4; t += gridDim.x) {
          if (t < 256) scan_task<16>(p, smem, t);
          else { const int u = t - 256; gemm_tile_w8<4>(smem, (const u16*)(wsp(p) + OFF_E) + (size_t)2 * T_ALL * 128, 256, W + W_G2, 192, 1024, 192, (u >> 2) * 256, (u & 3) * 256, ep); }
        }
      } PH_END(11)
      PH_BEGIN(12) phase_rwkv_out(p); PH_END(12)
      PH_BEGIN(13) {
        EpRes ep{outp(p), ctxr, outp(p), ctxr, mod + 5 * 6144 + 2 * 1024};
        for (int t = blockIdx.x; t < 128 * 4; t += gridDim.x) {
          int mt, nt; tile_map(t, 128 * 4, 4, mt, nt);
          gemm_tile_w8<4>(smem, (const u16*)(wsp(p) + OFF_C), 1024, W + W_O1, 1024, 1024, 1024, mt * 256, nt * 256, ep);
        }
      } PH_END(13)
      PH_BEGIN(14) phase_norm(p, 3); PH_END(14)
      PH_BEGIN(15) {
        EpFfn1 ep{(u16*)(wsp(p) + OFF_C)};
        for (int t = blockIdx.x; t < 128 * 22; t += gridDim.x) {
          int mt, nt; tile_map(t, 128 * 22, 22, mt, nt);
          gemm_tile_w8<4>(smem, (const u16*)(wsp(p) + OFF_A), 1024, W + W_13 + W13_SZ, 1024, 5632, 1024, mt * 256, nt * 256, ep);
        }
      } PH_END(15)
      PH_BEGIN(16) {
        EpRes ep{outp(p), ctxr, outp(p), ctxr, mod + 5 * 6144 + 5 * 1024};
        for (int t = blockIdx.x; t < 128 * 4; t += gridDim.x) {
          int mt, nt; tile_map(t, 128 * 4, 4, mt, nt);
          gemm_tile_w8<4>(smem, (const u16*)(wsp(p) + OFF_C), DFF, W + W_2 + W2_SZ, DFF, 1024, DFF, mt * 256, nt * 256, ep);
        }
      } PH_END(16)
    }
  }
}

extern "C" void kernel_launch(void* const* d_in, const int* in_sizes, int n_in, void* d_out, int out_size, void* d_ws,
                              size_t ws_size, hipStream_t stream) {
  static int grid_blocks = 0;
  if (!grid_blocks) {
    int dev = 0, cus = 0, per_cu = 0;
    (void)hipGetDevice(&dev);
    (void)hipDeviceGetAttribute(&cus, hipDeviceAttributeMultiprocessorCount, dev);
    (void)hipOccupancyMaxActiveBlocksPerMultiprocessor(&per_cu, mega, 512, 0);
    per_cu = 1;
    grid_blocks = cus * per_cu;
  }
  Params p{};
  for (int i = 0; i < 37; ++i) p.in[i] = (const float*)d_in[i];
  p.out = (float*)d_out;
  p.ws = (char*)d_ws;
  (void)hipMemsetAsync((char*)d_ws + OFF_BAR, 0, XCD_BAR_WORDS * sizeof(unsigned), stream);
  int lo = 0, hi = NPH, coop = 1;
  void* args[] = {&p, &lo, &hi, &coop};
  hipError_t e = hipLaunchCooperativeKernel((void*)mega, dim3(grid_blocks), dim3(512), args, 0, stream);
  if (e != hipSuccess) fprintf(stderr, "cooperative launch failed: %s (grid %d)\n", hipGetErrorString(e), grid_blocks);
}
```
